# Optimizing an MI355X kernel written in HIP

```python
import math
import jax, jax.numpy as jnp
from jax import lax
import numpy as np

D_MODEL = 1024
BATCH = 4
SEQ = 4096
DEPTH = 1

CHUNK = 64
MIX_WIDTH = D_MODEL
HG_WIDTH = MIX_WIDTH // 2
CONV_WIDTH = MIX_WIDTH - HG_WIDTH
HG_EXPAND = 128
HG_HEADS = HG_WIDTH // HG_EXPAND
HG_DK = HG_EXPAND
HG_DV = HG_WIDTH // HG_HEADS
CONV_K = 3
N_MEM = 256
XA_HEADS = 4
XA_HEAD_DIM = D_MODEL // XA_HEADS
D_FF = ((8 * D_MODEL // 3 + 255) // 256) * 256
IN_COLS = 4 * HG_WIDTH + 3 * CONV_WIDTH
EPS = 1e-6

kernel_name = "hymba_hgrn2_shortconv_macaron_block"


def rmsnorm(x, g):
    xf = x.astype(jnp.float32)
    y = xf * lax.rsqrt(jnp.mean(xf * xf, axis=-1, keepdims=True) + EPS)
    return (y * g.astype(jnp.float32)).astype(x.dtype)


def swiglu(h, w_gu, w_down):
    gate, up = jnp.split(h @ w_gu, 2, axis=-1)
    return (jax.nn.silu(gate) * up) @ w_down


def hgrn2_chunkwise(q, log_f, k, v):
    B, T, H, DK = q.shape
    DV = v.shape[-1]
    n = T // CHUNK

    def to_chunks(a):
        return a.astype(jnp.float32).reshape(B, n, CHUNK, H, a.shape[-1]).transpose(1, 0, 3, 2, 4)

    qc, lfc, kc, vc = to_chunks(q), to_chunks(log_f), to_chunks(k), to_chunks(v)
    causal = jnp.tril(jnp.ones((CHUNK, CHUNK), dtype=bool))

    def step(S, inp):
        qb, lfb, kb, vb = inp
        b = jnp.cumsum(lfb, axis=2)
        diff = b[:, :, :, None, :] - b[:, :, None, :, :]
        decay = jnp.exp(jnp.where(causal[None, None, :, :, None], diff, -jnp.inf))
        attn = jnp.einsum('bhtk,bhtsk,bhsk->bhts', qb, decay, kb)
        o = attn @ vb + jnp.einsum('bhtk,bhkv->bhtv', qb * jnp.exp(b), S)
        b_last = b[:, :, -1:, :]
        S_new = jnp.exp(b_last[:, :, 0, :])[..., None] * S + jnp.einsum(
            'bhsk,bhsv->bhkv', kb * jnp.exp(b_last - b), vb)
        return S_new, o

    S0 = jnp.zeros((B, H, DK, DV), jnp.float32)
    _, o = lax.scan(step, S0, (qc, lfc, kc, vc))
    return o.transpose(1, 0, 3, 2, 4).reshape(B, T, H, DV)


def causal_dwconv(u, w):
    C = u.shape[-1]
    return lax.conv_general_dilated(
        u, w.astype(u.dtype)[:, None, :], window_strides=(1,), padding=[(CONV_K - 1, 0)],
        dimension_numbers=('NWC', 'WIO', 'NWC'), feature_group_count=C)


def token_mixing(h, w_in, lb, hg_norm, conv_w, conv_norm, w_out):
    B, T, _ = h.shape
    p = h @ w_in
    q, fz, i, g, gb, gc, u = jnp.split(
        p, np.cumsum([HG_WIDTH] * 4 + [CONV_WIDTH] * 2).tolist(), axis=-1)
    lbf = lb.astype(jnp.float32)
    f = lbf + (1.0 - lbf) * jax.nn.sigmoid(fz.astype(jnp.float32))
    log_f = jnp.log(f)
    k = 1.0 - f
    shp = (B, T, HG_HEADS, HG_DK)
    o_hg = hgrn2_chunkwise(jax.nn.silu(q).reshape(shp), log_f.reshape(shp),
                           k.reshape(shp), i.reshape(B, T, HG_HEADS, HG_DV))
    o_hg = rmsnorm(o_hg.astype(h.dtype), hg_norm).reshape(B, T, HG_WIDTH) * jax.nn.silu(g)
    o_cv = rmsnorm(gb * causal_dwconv(gc * u, conv_w), conv_norm)
    return jnp.concatenate([o_hg, o_cv], axis=-1) @ w_out


def cross_attention(h, m, wq, wkv, wo):
    B, T, _ = h.shape
    M = m.shape[1]
    q = (h @ wq).reshape(B, T, XA_HEADS, XA_HEAD_DIM)
    k, v = jnp.split(m @ wkv, 2, axis=-1)
    k = k.reshape(B, M, XA_HEADS, XA_HEAD_DIM)
    v = v.reshape(B, M, XA_HEADS, XA_HEAD_DIM)
    s = jnp.einsum('bthd,bmhd->bhtm', q, k).astype(jnp.float32) * (1.0 / math.sqrt(XA_HEAD_DIM))
    pr = jax.nn.softmax(s, axis=-1).astype(v.dtype)
    o = jnp.einsum('bhtm,bmhd->bthd', pr, v).reshape(B, T, D_MODEL)
    return o @ wo


def setup_inputs(seed: int = 0) -> dict:
    key = jax.random.key(seed)
    ks = iter(jax.random.split(key, 32))

    def nrm(shape, scale):
        return jax.random.normal(next(ks), shape, jnp.float32) * scale

    def gain(shape):
        return 1.0 + nrm(shape, 0.02)

    L = DEPTH
    return {
        "x": nrm((BATCH, SEQ, D_MODEL), 1.0),
        "mem": nrm((BATCH, N_MEM, D_MODEL), 1.0),
        "ffn1_norm": gain((L, D_MODEL)),
        "ffn1_w_gu": nrm((L, D_MODEL, 2 * D_FF), D_MODEL ** -0.5),
        "ffn1_w_down": nrm((L, D_FF, D_MODEL), D_FF ** -0.5),
        "mix_norm": gain((L, D_MODEL)),
        "w_in": nrm((L, D_MODEL, IN_COLS), D_MODEL ** -0.5),
        "lb_logits": nrm((DEPTH + 1, HG_WIDTH), 0.5),
        "hg_norm": gain((L, HG_DV)),
        "conv_w": nrm((L, CONV_K, CONV_WIDTH), CONV_K ** -0.5),
        "conv_norm": gain((L, CONV_WIDTH)),
        "w_out": nrm((L, MIX_WIDTH, D_MODEL), MIX_WIDTH ** -0.5),
        "xa_norm": gain((L, D_MODEL)),
        "mem_norm": gain((L, D_MODEL)),
        "xa_wq": nrm((L, D_MODEL, D_MODEL), D_MODEL ** -0.5),
        "xa_wkv": nrm((L, D_MODEL, 2 * D_MODEL), D_MODEL ** -0.5),
        "xa_wo": nrm((L, D_MODEL, D_MODEL), D_MODEL ** -0.5),
        "ffn2_norm": gain((L, D_MODEL)),
        "ffn2_w_gu": nrm((L, D_MODEL, 2 * D_FF), D_MODEL ** -0.5),
        "ffn2_w_down": nrm((L, D_FF, D_MODEL), D_FF ** -0.5),
        "final_norm": gain((D_MODEL,)),
    }


def reference(x, mem, ffn1_norm, ffn1_w_gu, ffn1_w_down, mix_norm, w_in, lb_logits,
              hg_norm, conv_w, conv_norm, w_out, xa_norm, mem_norm, xa_wq, xa_wkv, xa_wo,
              ffn2_norm, ffn2_w_gu, ffn2_w_down, final_norm):
    lower_bounds = jnp.cumsum(jax.nn.softmax(lb_logits.astype(jnp.float32), axis=0), axis=0)
    for l in range(DEPTH):
        x = x + 0.5 * swiglu(rmsnorm(x, ffn1_norm[l]), ffn1_w_gu[l], ffn1_w_down[l])
        x = x + token_mixing(rmsnorm(x, mix_norm[l]), w_in[l], lower_bounds[l],
                             hg_norm[l], conv_w[l], conv_norm[l], w_out[l])
        x = x + cross_attention(rmsnorm(x, xa_norm[l]), rmsnorm(mem, mem_norm[l]),
                                xa_wq[l], xa_wkv[l], xa_wo[l])
        x = x + 0.5 * swiglu(rmsnorm(x, ffn2_norm[l]), ffn2_w_gu[l], ffn2_w_down[l])
    return rmsnorm(x, final_norm)
```

```cpp
#include <hip/hip_runtime.h>
#include <hip/hip_cooperative_groups.h>
#include <cstdio>
#include <cstdint>
namespace cg = cooperative_groups;
namespace pg8 {
#define PG8_LAS __attribute__((address_space(3)))
typedef unsigned short bf16_t;
typedef short bf16x8 __attribute__((ext_vector_type(8)));
typedef float f32x4 __attribute__((ext_vector_type(4)));
typedef unsigned u32x4 __attribute__((ext_vector_type(4)));
constexpr int BM = 256, BK = 64, HALF = 128, HTB = HALF * BK * 2  , STAGE_BYTES = 8 * HTB, NXCD = 8, WGM = 8;

__host__ __device__ __forceinline__ int lds_byte(int r, int c) { const int st = (r >> 4) * 2 + (c >> 5), rr = r & 15, cc = c & 31, ob = rr * 64 + cc * 2; return st * 1024 + (ob ^ (((ob >> 9) & 1) << 5)); }
__host__ __device__ __forceinline__ void stage_rc(int b, int& R, int& C) { const int st = b / 1024, sb = b % 1024, swz = sb ^ (((sb >> 9) & 1) << 5); R = (st >> 1) * 16 + swz / 64; C = (st & 1) * 32 + (swz % 64) / 2; }
__host__ __device__ __forceinline__ int perm32(int rho) { const int n = rho >> 4, i = rho & 15; return 8 * (i >> 2) + 4 * n + (i & 3); }

struct Unit { int pm, pn; };
struct Gemm { const bf16_t* A; const bf16_t* Bt; int M, N, K; };

struct StaticOrder {
    int nM, nN, nwg, G, c;
    __host__ __device__ void init(int M, int N, int G_, int c_) { nM = M / BM; nN = N / BM; nwg = nM * nN; G = G_; c = c_; }
    __host__ __device__ bool next(int i, Unit& u) const {
        const long L = (long)i * G + c; if (L >= nwg) return false;
        int wgid = (int)L; { const int q = nwg / NXCD, r = nwg % NXCD, xcd = wgid % NXCD, off = wgid / NXCD; wgid = (xcd < r ? xcd * (q + 1) : r * (q + 1) + (xcd - r) * q) + off; }
        const int nig = WGM * nN, gid = wgid / nig, fm = gid * WGM, gsz = (nM - fm) < WGM ? (nM - fm) : WGM;
        u.pm = fm + ((wgid % nig) % gsz); u.pn = (wgid % nig) / gsz; return true;
    }
    __device__ __forceinline__ void a_ready(const Unit&) const {}
    __device__ __forceinline__ void done(const Unit&) const {}
};
struct SemiDynOrder : StaticOrder {
    unsigned* q;
    PG8_LAS unsigned* slot;
    __device__ __forceinline__ bool next(int i, Unit& u) const {
        if (i < 5) return StaticOrder::next(i, u);
        if (i > 5) return false;
        const int x = c & 7;
        if (threadIdx.x == 0) { const unsigned k = __hip_atomic_fetch_add(q + 64 * x, 1u, __ATOMIC_RELAXED, __HIP_MEMORY_SCOPE_AGENT); *slot = k; }
        asm volatile("s_waitcnt vmcnt(0) lgkmcnt(0)" ::: "memory"); __builtin_amdgcn_s_barrier(); asm volatile("" ::: "memory");
        const unsigned k = *slot; const int per = nwg / NXCD, extra = per - 5 * G / NXCD;
        if ((int)k >= extra) return false;
        const int wgid = x * per + 5 * G / NXCD + (int)k;
        const int nig = WGM * nN, gid = wgid / nig, fm = gid * WGM, gsz = (nM - fm) < WGM ? (nM - fm) : WGM;
        u.pm = fm + ((wgid % nig) % gsz); u.pn = (wgid % nig) / gsz; return true;
    }
};

typedef float cvf32x2_t __attribute__((ext_vector_type(2))); typedef __bf16 cvbf16x2_t __attribute__((ext_vector_type(2)));
__device__ __forceinline__ unsigned cvt_pk_bf16(float lo, float hi) { cvf32x2_t v = {lo, hi}; cvbf16x2_t b = __builtin_convertvector(v, cvbf16x2_t); return __builtin_bit_cast(unsigned, b); }
typedef float f32x2 __attribute__((ext_vector_type(2)));
typedef unsigned wt_u32x2 __attribute__((ext_vector_type(2)));
#ifndef WT_STORES
#define WT_STORES 0
#endif
__device__ __forceinline__ void st_wt16(void* p, u32x4 v) {
#if WT_STORES
    asm volatile("global_store_dwordx4 %0, %1, off sc1\n\ts_nop 1" :: "v"(p), "v"(v) : "memory");
#else
    *(u32x4*)p = v;
#endif
}
__device__ __forceinline__ void st_wt8(void* p, wt_u32x2 v) {
#if WT_STORES && 0
    asm volatile("global_store_dwordx2 %0, %1, off sc1\n\ts_nop 1" :: "v"(p), "v"(v) : "memory");
#else
    *(wt_u32x2*)p = v;
#endif
}
template <class Epi, class Sched, bool ALIGN_EPI = false, bool SP2 = false>
__device__ __forceinline__ void gemm_phase(PG8_LAS unsigned char* lds, const Gemm g, const Sched& S, const Epi& E) {
    const int tid = threadIdx.x, wid = __builtin_amdgcn_readfirstlane(tid >> 6), lane = tid & 63, wr = wid >> 2, wc = wid & 3, fr = lane & 15, fq = lane >> 4;
    const int K = g.K, nt = K / BK;
    unsigned voffA[2], voffB[2];
#pragma unroll
    for (int i = 0; i < 2; ++i) { int R, C; stage_rc(tid * 16 + i * 8192, R, C); const int Rb = Epi::PERM ? ((R & ~31) + perm32(R & 31)) : R;
        voffA[i] = (unsigned)(R * K + C) * 2u; voffB[i] = (unsigned)(Rb * K + C) * 2u; }
    const size_t kstep = (size_t)(BK * 2);
    const size_t hstep = (size_t)HALF * K * 2;
    const size_t tstep = 2 * hstep;
    const unsigned ldsw = (unsigned)wid * 1024u;
    const int aoff = lds_byte(wr * 64 + fr, fq * 8), boff = lds_byte(wc * 32 + fr, fq * 8);
#define PG8_SA(b, h) (((b) * 2 + (h)) * HTB)
#define PG8_SB(b, h) ((4 + (b) * 2 + (h)) * HTB)
#define PG8_STAGE(bufoff, gbase, voff) do { _Pragma("unroll") for (int _i = 0; _i < 2; ++_i) \
        __builtin_amdgcn_global_load_lds((const unsigned*)((const char*)(gbase) + (voff)[_i]), (PG8_LAS unsigned*)(lds + (bufoff) + ldsw + _i * 8192), 16, 0, 0); } while (0)
#define PG8_LDA(dst, b, h) do { _Pragma("unroll") for (int m = 0; m < 4; ++m) _Pragma("unroll") for (int k = 0; k < 2; ++k) dst[m][k] = *(const PG8_LAS bf16x8*)(lds + PG8_SA(b, h) + aoff + m * 2048 + k * 1024); } while (0)
#define PG8_LDB(dst, b, h) do { _Pragma("unroll") for (int n = 0; n < 2; ++n) _Pragma("unroll") for (int k = 0; k < 2; ++k) dst[n][k] = *(const PG8_LAS bf16x8*)(lds + PG8_SB(b, h) + boff + n * 2048 + k * 1024); } while (0)
#define PG8_MMA(ai, bj, At, Bt) do { __builtin_amdgcn_s_setprio(1); _Pragma("unroll") for (int m = 0; m < 4; ++m) _Pragma("unroll") for (int n = 0; n < 2; ++n) _Pragma("unroll") for (int k = 0; k < 2; ++k) \
        acc[ai][bj][m][n] = __builtin_amdgcn_mfma_f32_16x16x32_bf16(Bt[n][k], At[m][k], acc[ai][bj][m][n], 0, 0, 0); __builtin_amdgcn_s_setprio(0); } while (0)
#define PG8_WAIT_V(n) asm volatile("s_waitcnt vmcnt(" #n ")" ::: "memory")
#define PG8_WAIT_L(n) asm volatile("s_waitcnt lgkmcnt(" #n ")" ::: "memory")
#define PG8_BAR __builtin_amdgcn_s_barrier()
#define PG8_SCHED __builtin_amdgcn_sched_barrier(0)
    Unit cur, nxt; int ui = 0;
    if (!S.next(0, cur)) return;
    f32x4 acc[2][2][4][2];
#pragma unroll
    for (int a = 0; a < 2; ++a)
#pragma unroll
        for (int b = 0; b < 2; ++b)
#pragma unroll
            for (int m = 0; m < 4; ++m)
#pragma unroll
                for (int n = 0; n < 2; ++n) acc[a][b][m][n] = (f32x4){0.f, 0.f, 0.f, 0.f};
    bf16x8 At[4][2], B0[2][2], B1[2][2];
    const char* cA = (const char*)g.A + (size_t)cur.pm * tstep; const char* cB = (const char*)g.Bt + (size_t)cur.pn * tstep;
    S.a_ready(cur);
    if constexpr (SP2) {
        PG8_STAGE(PG8_SB(0, 0), cB, voffB); PG8_STAGE(PG8_SB(0, 1), cB + hstep, voffB); PG8_STAGE(PG8_SA(0, 0), cA, voffA); PG8_STAGE(PG8_SA(0, 1), cA + hstep, voffA);
        if (wr == 1) PG8_BAR;
        PG8_WAIT_V(2); PG8_BAR;
        PG8_STAGE(PG8_SB(1, 0), cB + kstep, voffB); PG8_STAGE(PG8_SA(1, 0), cA + kstep, voffA); PG8_STAGE(PG8_SB(1, 1), cB + hstep + kstep, voffB);
        PG8_WAIT_V(6); PG8_BAR;
    } else {
        PG8_STAGE(PG8_SB(0, 0), cB, voffB); PG8_STAGE(PG8_SA(0, 0), cA, voffA); PG8_STAGE(PG8_SB(0, 1), cB + hstep, voffB); PG8_STAGE(PG8_SA(0, 1), cA + hstep, voffA);
        if (wr == 1) PG8_BAR;
        PG8_WAIT_V(4); PG8_BAR;
        PG8_STAGE(PG8_SB(1, 0), cB + kstep, voffB); PG8_STAGE(PG8_SA(1, 0), cA + kstep, voffA); PG8_STAGE(PG8_SB(1, 1), cB + hstep + kstep, voffB);
        PG8_WAIT_V(6); PG8_BAR;
    }
    for (;;) {
        const bool has_next = S.next(ui + 1, nxt);
        const char* nA = has_next ? (const char*)g.A + (size_t)nxt.pm * tstep : cA; const char* nB = has_next ? (const char*)g.Bt + (size_t)nxt.pn * tstep : cB;
        for (int t = 0; t < nt; t += 2) {
            const bool last = (t == nt - 2);
            const char* a1 = cA + (size_t)(t + 1) * kstep;
            const char* a2 = last ? nA : cA + (size_t)(t + 2) * kstep; const char* b2 = last ? nB : cB + (size_t)(t + 2) * kstep;
            const char* a3 = a2 + kstep; const char* b3 = b2 + kstep;
            if (last && has_next) S.a_ready(nxt);
            if constexpr (SP2) {
            PG8_LDB(B0, 0, 0); PG8_LDB(B1, 0, 1); PG8_SCHED; PG8_LDA(At, 0, 0); PG8_STAGE(PG8_SA(1, 1), a1 + hstep, voffA);
            PG8_WAIT_V(8); PG8_WAIT_L(0); PG8_BAR; PG8_MMA(0, 0, At, B0); PG8_MMA(0, 1, At, B1); PG8_BAR; PG8_SCHED;
            PG8_LDA(At, 0, 1); PG8_STAGE(PG8_SB(0, 0), b2, voffB); PG8_STAGE(PG8_SB(0, 1), b2 + hstep, voffB); PG8_STAGE(PG8_SA(0, 0), a2, voffA);
            PG8_WAIT_V(8); PG8_WAIT_L(0); PG8_BAR; PG8_MMA(1, 0, At, B0); PG8_MMA(1, 1, At, B1); PG8_BAR; PG8_SCHED;
            PG8_LDB(B0, 1, 0); PG8_LDB(B1, 1, 1); PG8_SCHED; PG8_LDA(At, 1, 0); PG8_STAGE(PG8_SA(0, 1), a2 + hstep, voffA);
            PG8_WAIT_V(8); PG8_WAIT_L(0); PG8_BAR; PG8_MMA(0, 0, At, B0); PG8_MMA(0, 1, At, B1); PG8_BAR; PG8_SCHED;
            PG8_LDA(At, 1, 1); PG8_STAGE(PG8_SB(1, 0), b3, voffB); PG8_STAGE(PG8_SB(1, 1), b3 + hstep, voffB); PG8_STAGE(PG8_SA(1, 0), a3, voffA);
            PG8_WAIT_V(8); PG8_WAIT_L(0); PG8_BAR; PG8_MMA(1, 0, At, B0); PG8_MMA(1, 1, At, B1); PG8_BAR; PG8_SCHED;
            } else {
            PG8_LDB(B0, 0, 0); PG8_SCHED; PG8_LDA(At, 0, 0); PG8_STAGE(PG8_SA(1, 1), a1 + hstep, voffA);
            PG8_WAIT_L(8); PG8_BAR; PG8_WAIT_L(0); PG8_MMA(0, 0, At, B0); PG8_BAR; PG8_SCHED;
            PG8_LDB(B1, 0, 1); PG8_STAGE(PG8_SB(0, 0), b2, voffB);
            PG8_BAR; PG8_WAIT_L(0); PG8_MMA(0, 1, At, B1); PG8_BAR;
            PG8_LDA(At, 0, 1); PG8_STAGE(PG8_SA(0, 0), a2, voffA);
            PG8_BAR; PG8_WAIT_L(0); PG8_MMA(1, 0, At, B0); PG8_BAR; PG8_SCHED;
            PG8_STAGE(PG8_SB(0, 1), b2 + hstep, voffB);
            PG8_WAIT_V(6); PG8_BAR; PG8_MMA(1, 1, At, B1); PG8_BAR;
            PG8_LDB(B0, 1, 0); PG8_SCHED; PG8_LDA(At, 1, 0); PG8_STAGE(PG8_SA(0, 1), a2 + hstep, voffA);
            PG8_WAIT_L(8); PG8_BAR; PG8_WAIT_L(0); PG8_MMA(0, 0, At, B0); PG8_BAR; PG8_SCHED;
            PG8_LDB(B1, 1, 1); PG8_STAGE(PG8_SB(1, 0), b3, voffB);
            PG8_BAR; PG8_WAIT_L(0); PG8_MMA(0, 1, At, B1); PG8_BAR;
            PG8_LDA(At, 1, 1); PG8_STAGE(PG8_SA(1, 0), a3, voffA);
            PG8_BAR; PG8_WAIT_L(0); PG8_MMA(1, 0, At, B0); PG8_BAR; PG8_SCHED;
            PG8_STAGE(PG8_SB(1, 1), b3 + hstep, voffB);
            PG8_WAIT_V(6); PG8_BAR; PG8_MMA(1, 1, At, B1); PG8_BAR;
            }
        }
        if constexpr (ALIGN_EPI) { if (wr == 0) PG8_BAR; }
        if constexpr (!Epi::AFTER_DRAIN) { E(acc, cur, wr, wc, fr, fq); S.done(cur); }
        if (!has_next) break;
#pragma unroll
        for (int a = 0; a < 2; ++a)
#pragma unroll
            for (int b = 0; b < 2; ++b)
#pragma unroll
                for (int m = 0; m < 4; ++m)
#pragma unroll
                    for (int n = 0; n < 2; ++n) acc[a][b][m][n] = (f32x4){0.f, 0.f, 0.f, 0.f};
        cur = nxt; cA = nA; cB = nB; ++ui;
        if constexpr (ALIGN_EPI) { if (wr == 1) PG8_BAR; }
    }
    PG8_WAIT_V(0);
    if constexpr (!ALIGN_EPI) { if (wr == 0) PG8_BAR; }
    PG8_BAR;
    if constexpr (Epi::AFTER_DRAIN) { E.fused(acc, cur, wr, wc, fr, fq, lds, wid, lane); S.done(cur); }
#undef PG8_SA
#undef PG8_SB
#undef PG8_STAGE
#undef PG8_LDA
#undef PG8_LDB
#undef PG8_MMA
#undef PG8_WAIT_V
#undef PG8_WAIT_L
#undef PG8_BAR
#undef PG8_SCHED
}
}
namespace pg8 {
typedef unsigned u32x2 __attribute__((ext_vector_type(2)));
typedef _Float16 f16x4 __attribute__((ext_vector_type(4)));
constexpr float RMS_EPS = 1e-6f;
__device__ __forceinline__ float fsigm(float x) { return __builtin_amdgcn_rcpf(1.f + __expf(-x)); }
__device__ __forceinline__ float fsilu(float x) { return x * fsigm(x); }
__device__ __forceinline__ float row_rs(const float* ssq, int row) { return ssq ? rsqrtf(ssq[row] * (1.f / 1024.f) + RMS_EPS) : 1.f; }

struct EpiSwiglu {
    static constexpr bool PERM = true, AFTER_DRAIN = false;
    bf16_t* H; int ldh; const float* ssq;
    __device__ __forceinline__ void operator()(const f32x4 (&acc)[2][2][4][2], const Unit& u, int wr, int wc, int fr, int fq) const {
        const int row0 = u.pm * BM + wr * 64 + fr, col0 = u.pn * HALF + wc * 32 + 8 * fq;
#pragma unroll
        for (int ai = 0; ai < 2; ++ai)
#pragma unroll
            for (int m = 0; m < 4; ++m) { const int row = row0 + ai * HALF + m * 16; const float rs = row_rs(ssq, row);
                u32x4 w; unsigned pk[4];
#pragma unroll
                for (int n = 0; n < 2; ++n) { const f32x4 g = acc[ai][0][m][n] * rs, up = acc[ai][1][m][n] * rs;
                    pk[2 * n] = cvt_pk_bf16(fsilu(g[0]) * up[0], fsilu(g[1]) * up[1]); pk[2 * n + 1] = cvt_pk_bf16(fsilu(g[2]) * up[2], fsilu(g[3]) * up[3]); }
                w.x = pk[0]; w.y = pk[1]; w.z = pk[2]; w.w = pk[3];
                st_wt16(H + (size_t)row * ldh + col0, w); }
    }
};
struct EpiScale {
    static constexpr bool PERM = true, AFTER_DRAIN = false;
    bf16_t* O; int ldc; const float* ssq;
    __device__ __forceinline__ void operator()(const f32x4 (&acc)[2][2][4][2], const Unit& u, int wr, int wc, int fr, int fq) const {
        const int row0 = u.pm * BM + wr * 64 + fr, col0 = u.pn * BM + wc * 32 + 8 * fq;
#pragma unroll
        for (int ai = 0; ai < 2; ++ai)
#pragma unroll
            for (int m = 0; m < 4; ++m) { const int row = row0 + ai * HALF + m * 16; const float rs = row_rs(ssq, row);
#pragma unroll
                for (int bj = 0; bj < 2; ++bj) { const f32x4 v0 = acc[ai][bj][m][0] * rs, v1 = acc[ai][bj][m][1] * rs; u32x4 w;
                    w.x = cvt_pk_bf16(v0[0], v0[1]); w.y = cvt_pk_bf16(v0[2], v0[3]); w.z = cvt_pk_bf16(v1[0], v1[1]); w.w = cvt_pk_bf16(v1[2], v1[3]);
                    st_wt16(O + (size_t)row * ldc + col0 + bj * HALF, w); } }
    }
};
__device__ __forceinline__ void panel_sync(unsigned* cnt, int pm, int wid, int lane) {
    asm volatile("s_waitcnt vmcnt(0) lgkmcnt(0)" ::: "memory"); __builtin_amdgcn_s_barrier(); asm volatile("" ::: "memory");
    if (wid == 0) {
        if (lane == 0) { __builtin_amdgcn_fence(__ATOMIC_RELEASE, "agent"); asm volatile("s_waitcnt vmcnt(0)" ::: "memory"); __hip_atomic_fetch_add(cnt + 64 * pm, 1u, __ATOMIC_RELAXED, __HIP_MEMORY_SCOPE_AGENT); }
        unsigned sp = 0;
        while ((unsigned)__builtin_amdgcn_readfirstlane(__hip_atomic_load(cnt + 64 * pm, __ATOMIC_RELAXED, __HIP_MEMORY_SCOPE_AGENT)) < 4u) { __builtin_amdgcn_s_sleep(2); if (++sp > (1u << 22)) break; }
        __builtin_amdgcn_fence(__ATOMIC_ACQUIRE, "agent");
        asm volatile("s_waitcnt vmcnt(0)" ::: "memory");
    }
    asm volatile("" ::: "memory"); __builtin_amdgcn_s_barrier(); asm volatile("" ::: "memory");
}
__device__ __forceinline__ float bfl(unsigned w) { return __uint_as_float(w << 16); }
__device__ __forceinline__ float bfh(unsigned w) { return __uint_as_float(w & 0xffff0000u); }
struct EpiResid {
    static constexpr bool PERM = true, AFTER_DRAIN = true;
    const float* xin32; bf16_t* xb; float* ssq_out; float scale; unsigned* psync;
    __device__ __forceinline__ void fused(f32x4 (&acc)[2][2][4][2], const Unit& u, int wr, int wc, int fr, int fq, PG8_LAS unsigned char* lds, int wid, int lane) const {
        PG8_LAS float* P = (PG8_LAS float*)lds;
        const int row0 = u.pm * BM + wr * 64 + fr, col0 = u.pn * BM + wc * 32 + 8 * fq;
#pragma unroll
        for (int ai = 0; ai < 2; ++ai)
#pragma unroll
            for (int m = 0; m < 4; ++m) { const int row = row0 + ai * HALF + m * 16; const size_t off = (size_t)row * 1024 + col0; float ss = 0.f;
#pragma unroll
                for (int bj = 0; bj < 2; ++bj) { const size_t o = off + bj * HALF; f32x4 x0, x1;
                    if (xin32) { x0 = *(const f32x4*)(xin32 + o); x1 = *(const f32x4*)(xin32 + o + 4); }
                    else { const u32x4 w = *(const u32x4*)(xb + o); x0 = (f32x4){bfl(w.x), bfh(w.x), bfl(w.y), bfh(w.y)}; x1 = (f32x4){bfl(w.z), bfh(w.z), bfl(w.w), bfh(w.w)}; }
                    const f32x4 v0 = x0 + acc[ai][bj][m][0] * scale, v1 = x1 + acc[ai][bj][m][1] * scale;
                    ss += ((v0[0] * v0[0] + v0[1] * v0[1]) + (v0[2] * v0[2] + v0[3] * v0[3])) + ((v1[0] * v1[0] + v1[1] * v1[1]) + (v1[2] * v1[2] + v1[3] * v1[3]));
                    u32x4 w; w.x = cvt_pk_bf16(v0[0], v0[1]); w.y = cvt_pk_bf16(v0[2], v0[3]); w.z = cvt_pk_bf16(v1[0], v1[1]); w.w = cvt_pk_bf16(v1[2], v1[3]); st_wt16(xb + o, w); }
                ss += __shfl_xor(ss, 16); ss += __shfl_xor(ss, 32);
                if (fq == 0) P[(ai * HALF + wr * 64 + m * 16 + fr) * 4 + wc] = ss; }
        asm volatile("s_waitcnt lgkmcnt(0)" ::: "memory"); __builtin_amdgcn_s_barrier(); asm volatile("" ::: "memory");
        const int t = wid * 64 + lane;
        if (t < 256) { const f32x4 p = *(const PG8_LAS f32x4*)(P + t * 4); unsafeAtomicAdd(ssq_out + u.pm * BM + t, (p[0] + p[1]) + (p[2] + p[3])); }
        asm volatile("s_waitcnt lgkmcnt(0)" ::: "memory"); __builtin_amdgcn_s_barrier(); asm volatile("" ::: "memory");
        if (psync) panel_sync(psync, u.pm, wid, lane);
    }
};
struct EpiFinal {
    static constexpr bool PERM = true, AFTER_DRAIN = true;
    const bf16_t* xb; float* out; float* ssq; unsigned* cnt; const float* gain; float scale;
    __device__ __forceinline__ void fused(f32x4 (&acc)[2][2][4][2], const Unit& u, int wr, int wc, int fr, int fq, PG8_LAS unsigned char* lds, int wid, int lane) const {
        PG8_LAS float* P = (PG8_LAS float*)lds;
        const int row0 = u.pm * BM + wr * 64 + fr, col0 = u.pn * BM + wc * 32 + 8 * fq;
#pragma unroll
        for (int ai = 0; ai < 2; ++ai)
#pragma unroll
            for (int m = 0; m < 4; ++m) { const int row = row0 + ai * HALF + m * 16; const size_t off = (size_t)row * 1024 + col0; float ss = 0.f;
#pragma unroll
                for (int bj = 0; bj < 2; ++bj) { const u32x4 w = *(const u32x4*)(xb + off + bj * HALF);
                    const f32x4 x0 = {bfl(w.x), bfh(w.x), bfl(w.y), bfh(w.y)}, x1 = {bfl(w.z), bfh(w.z), bfl(w.w), bfh(w.w)};
                    const f32x4 v0 = x0 + acc[ai][bj][m][0] * scale, v1 = x1 + acc[ai][bj][m][1] * scale; acc[ai][bj][m][0] = v0; acc[ai][bj][m][1] = v1;
                    ss += ((v0[0] * v0[0] + v0[1] * v0[1]) + (v0[2] * v0[2] + v0[3] * v0[3])) + ((v1[0] * v1[0] + v1[1] * v1[1]) + (v1[2] * v1[2] + v1[3] * v1[3])); }
                ss += __shfl_xor(ss, 16); ss += __shfl_xor(ss, 32);
                if (fq == 0) P[(ai * HALF + wr * 64 + m * 16 + fr) * 4 + wc] = ss; }
        asm volatile("s_waitcnt lgkmcnt(0)" ::: "memory"); __builtin_amdgcn_s_barrier(); asm volatile("" ::: "memory");
        const int t = wid * 64 + lane;
        if (t < 256) { const f32x4 p = *(const PG8_LAS f32x4*)(P + t * 4); unsafeAtomicAdd(ssq + u.pm * BM + t, (p[0] + p[1]) + (p[2] + p[3])); }
        asm volatile("s_waitcnt vmcnt(0) lgkmcnt(0)" ::: "memory"); __builtin_amdgcn_s_barrier(); asm volatile("" ::: "memory");
        if (wid == 0) {
            if (lane == 0) __hip_atomic_fetch_add(cnt + 64 * u.pm, 1u, __ATOMIC_RELAXED, __HIP_MEMORY_SCOPE_AGENT);
            unsigned sp = 0;
            while ((unsigned)__builtin_amdgcn_readfirstlane(__hip_atomic_load(cnt + 64 * u.pm, __ATOMIC_RELAXED, __HIP_MEMORY_SCOPE_AGENT)) < 4u) { __builtin_amdgcn_s_sleep(2); if (++sp > (1u << 22)) break; }
        }
        asm volatile("s_waitcnt vmcnt(0) lgkmcnt(0)" ::: "memory"); __builtin_amdgcn_s_barrier(); asm volatile("" ::: "memory");
#pragma unroll
        for (int ai = 0; ai < 2; ++ai)
#pragma unroll
            for (int m = 0; m < 4; ++m) { const int row = row0 + ai * HALF + m * 16; const size_t off = (size_t)row * 1024 + col0;
                const float rs = rsqrtf(__hip_atomic_load(ssq + row, __ATOMIC_RELAXED, __HIP_MEMORY_SCOPE_AGENT) * (1.f / 1024.f) + RMS_EPS);
#pragma unroll
                for (int bj = 0; bj < 2; ++bj)
#pragma unroll
                    for (int n = 0; n < 2; ++n) { const f32x4 g = *(const f32x4*)(gain + col0 + bj * HALF + n * 4); *(f32x4*)(out + off + bj * HALF + n * 4) = acc[ai][bj][m][n] * rs * g; } }
    }
};
struct EpiWin {
    static constexpr bool PERM = true, AFTER_DRAIN = false;
    bf16_t *QS, *VV, *GS, *BC, *CU; _Float16* LF; const float* ssq; const float* lbl; int pn0;
    __device__ __forceinline__ void operator()(const f32x4 (&acc)[2][2][4][2], const Unit& u, int wr, int wc, int fr, int fq) const {
        const int row0 = u.pm * BM + wr * 64 + fr; const int pn = u.pn + pn0; const int cw = wc * 32 + 8 * fq;
        if (pn >= 10) {
#pragma unroll
            for (int ai = 0; ai < 2; ++ai)
#pragma unroll
                for (int m = 0; m < 4; ++m) { const int row = row0 + ai * HALF + m * 16; const float rs = row_rs(ssq, row); const float rs2 = rs * rs;
                    const f32x4 v0 = acc[ai][0][m][0] * acc[ai][1][m][0] * rs2, v1 = acc[ai][0][m][1] * acc[ai][1][m][1] * rs2; u32x4 w;
                    w.x = cvt_pk_bf16(v0[0], v0[1]); w.y = cvt_pk_bf16(v0[2], v0[3]); w.z = cvt_pk_bf16(v1[0], v1[1]); w.w = cvt_pk_bf16(v1[2], v1[3]);
                    *(u32x4*)(CU + (size_t)row * 512 + (pn - 10) * HALF + cw) = w; }
            return;
        }
        const int grp = pn >> 1;
        const int cbase = (pn & 1) * BM + cw;
        if (grp == 1) {
            float lb[2][2][4];
#pragma unroll
            for (int bj = 0; bj < 2; ++bj)
#pragma unroll
                for (int n = 0; n < 2; ++n) { const int c = cbase + bj * HALF + n * 4; const f32x4 l0 = *(const f32x4*)(lbl + c), l1 = *(const f32x4*)(lbl + 512 + c);
#pragma unroll
                    for (int j = 0; j < 4; ++j) lb[bj][n][j] = fsigm(l0[j] - l1[j]); }
#pragma unroll
            for (int ai = 0; ai < 2; ++ai)
#pragma unroll
                for (int m = 0; m < 4; ++m) { const int row = row0 + ai * HALF + m * 16; const float rs = row_rs(ssq, row);
#pragma unroll
                    for (int bj = 0; bj < 2; ++bj) { f16x4 o[2];
#pragma unroll
                        for (int n = 0; n < 2; ++n) { const f32x4 p = acc[ai][bj][m][n] * rs;
#pragma unroll
                            for (int j = 0; j < 4; ++j) { const float l = lb[bj][n][j]; const float f = l + (1.f - l) * fsigm(p[j]); o[n][j] = (_Float16)__logf(f); } }
                        const u32x2 a0 = __builtin_bit_cast(u32x2, o[0]), a1 = __builtin_bit_cast(u32x2, o[1]); u32x4 w; w.x = a0.x; w.y = a0.y; w.z = a1.x; w.w = a1.y;
                        *(u32x4*)(LF + (size_t)row * 512 + cbase + bj * HALF) = w; } }
            return;
        }
        bf16_t* dst = grp == 0 ? QS : (grp == 2 ? VV : (grp == 3 ? GS : BC)); const bool act = (grp == 0) || (grp == 3);
#pragma unroll
        for (int ai = 0; ai < 2; ++ai)
#pragma unroll
            for (int m = 0; m < 4; ++m) { const int row = row0 + ai * HALF + m * 16; const float rs = row_rs(ssq, row);
#pragma unroll
                for (int bj = 0; bj < 2; ++bj) { f32x4 p0 = acc[ai][bj][m][0] * rs, p1 = acc[ai][bj][m][1] * rs;
                    if (act) { p0[0] = fsilu(p0[0]); p0[1] = fsilu(p0[1]); p0[2] = fsilu(p0[2]); p0[3] = fsilu(p0[3]); p1[0] = fsilu(p1[0]); p1[1] = fsilu(p1[1]); p1[2] = fsilu(p1[2]); p1[3] = fsilu(p1[3]); }
                    u32x4 w; w.x = cvt_pk_bf16(p0[0], p0[1]); w.y = cvt_pk_bf16(p0[2], p0[3]); w.z = cvt_pk_bf16(p1[0], p1[1]); w.w = cvt_pk_bf16(p1[2], p1[3]);
                    *(u32x4*)(dst + (size_t)row * 512 + cbase + bj * HALF) = w; } }
    }
};
}
#define LAS __attribute__((address_space(3)))
typedef unsigned short bf16;
typedef unsigned v4u __attribute__((ext_vector_type(4)));
typedef unsigned v2u __attribute__((ext_vector_type(2)));
typedef float f32x4 __attribute__((ext_vector_type(4)));
typedef float f32x16 __attribute__((ext_vector_type(16)));
typedef short bf16x8 __attribute__((ext_vector_type(8)));
typedef short s16x4 __attribute__((ext_vector_type(4)));
constexpr int NWAVES = 8, NT = NWAVES * 64;
constexpr int M = 16384, D = 1024, FF = 2816, IC = 3584, SEQ = 4096, NB = 4, NMEM = 256;
constexpr float EPS = 1e-6f;
constexpr size_t MiB = 1u << 20;
constexpr size_t WS_SSQ = 0;
constexpr size_t WS_DEC = 512 * 1024;
constexpr size_t WS_WGU1 = 1 * MiB, WS_WD1 = 12 * MiB, WS_WIN = 18 * MiB, WS_WOUT = 25 * MiB, WS_WQ = 27 * MiB, WS_WKV = 29 * MiB, WS_WO = 33 * MiB, WS_WGU2 = 35 * MiB, WS_WD2 = 46 * MiB;
constexpr size_t WS_XB = 54 * MiB;
constexpr size_t WS_KB = 86 * MiB, WS_VT = 88 * MiB, WS_MEMN = 90 * MiB;
constexpr size_t WS_R = 96 * MiB;
constexpr size_t WS_H = WS_R;
constexpr size_t WS_QS = WS_R, WS_LF = WS_R + 16 * MiB, WS_VV = WS_R + 32 * MiB, WS_GS = WS_R + 48 * MiB, WS_BC = WS_R + 64 * MiB, WS_CU = WS_R + 80 * MiB;
constexpr size_t WS_ST = WS_R + 96 * MiB, WS_MIX = WS_R + 128 * MiB;
constexpr size_t WS_O = WS_ST;
constexpr size_t WS_END = 256 * MiB;
static_assert(WS_WD2 + (size_t)D * FF * 2 <= WS_XB && WS_MIX + (size_t)M * D * 2 <= WS_END && WS_H + (size_t)M * FF * 2 <= WS_END, "ws map");
constexpr int LDS_BYTES = 147456;
constexpr int MISC_OFF = LDS_BYTES - 64;
constexpr size_t WS_BAR = 400 * 1024, WS_CNT = WS_BAR + 16384, BAR_BYTES = 65536 + 4096;

__device__ __forceinline__ unsigned pk2(float lo, float hi) { return pg8::cvt_pk_bf16(lo, hi); }
__device__ __forceinline__ float bf2f(unsigned short u) { return __uint_as_float((unsigned)u << 16); }
__device__ __forceinline__ float wave_sum(float v) {
#pragma unroll
    for (int o = 1; o < 64; o <<= 1) v += __shfl_xor(v, o);
    return v;
}
#define LDS_WAIT() asm volatile("s_waitcnt lgkmcnt(0)" ::: "memory")
#define LBAR() do { asm volatile("s_waitcnt lgkmcnt(0)" ::: "memory"); __builtin_amdgcn_s_barrier(); asm volatile("" ::: "memory"); } while (0)

__device__ __forceinline__ int rowmap(int mode, int n0, int N) {
    if (mode == 1) { const int half = N / 2, isup = n0 >= half ? 1 : 0, j = n0 - isup * half; return (j / 128) * 256 + isup * 128 + (j % 128); }
    if (mode == 2) { if (n0 < 2560) return n0; int j = n0 - 2560; const int isu = j >= 512 ? 1 : 0; j -= isu * 512; return 2560 + (j / 128) * 256 + isu * 128 + (j % 128); }
    return n0;
}
struct P0Desc { const float* W; bf16* WT; const float* gain; float scale; int K, N, mode, item; };
__device__ __forceinline__ void p0_load(const P0Desc& d, float (&v)[32], int lane) {
    const int nblk = d.N / 32, kb = d.item / nblk, nb = d.item % nblk, k0 = 64 * kb, n0 = 32 * nb;
    const float* p = d.W + (size_t)(k0 + (lane >> 5)) * d.N + n0 + (lane & 31);
#pragma unroll
    for (int i = 0; i < 32; ++i) v[i] = p[(size_t)(2 * i) * d.N];
}
__device__ __forceinline__ void p0_store(const P0Desc& d, const float (&v)[32], LAS float* scr, int lane) {
    const int nblk = d.N / 32, kb = d.item / nblk, nb = d.item % nblk, k0 = 64 * kb, n0 = 32 * nb;
#pragma unroll
    for (int i = 0; i < 32; ++i) scr[(2 * i + (lane >> 5)) * 33 + (lane & 31)] = v[i];
    LDS_WAIT(); asm volatile("" ::: "memory");
    const int c = lane & 7; const int r0 = rowmap(d.mode, n0, d.N);
    f32x4 g0 = {d.scale, d.scale, d.scale, d.scale}, g1 = g0;
    if (d.gain) { g0 = *(const f32x4*)(d.gain + k0 + 8 * c) * d.scale; g1 = *(const f32x4*)(d.gain + k0 + 8 * c + 4) * d.scale; }
#pragma unroll
    for (int j = 0; j < 4; ++j) { const int n = (lane >> 3) + 8 * j; const LAS float* q = scr + (8 * c) * 33 + n;
        v4u o; o.x = pk2(q[0 * 33] * g0[0], q[1 * 33] * g0[1]); o.y = pk2(q[2 * 33] * g0[2], q[3 * 33] * g0[3]); o.z = pk2(q[4 * 33] * g1[0], q[5 * 33] * g1[1]); o.w = pk2(q[6 * 33] * g1[2], q[7 * 33] * g1[3]);
        pg8::st_wt16(d.WT + (size_t)(r0 + n) * d.K + k0 + 8 * c, o); }
    LDS_WAIT(); asm volatile("" ::: "memory");
}

struct Args { const float* in[21]; float* out; unsigned char* ws; int ph_lo, ph_hi; };
enum { I_X = 0, I_MEM, I_F1N, I_F1GU, I_F1D, I_MIXN, I_WIN, I_LB, I_HGN, I_CONVW, I_CONVN, I_WOUT, I_XAN, I_MEMNORM, I_WQ, I_WKV, I_WO, I_F2N, I_F2GU, I_F2D, I_FINN };

struct P0Tab { int in_w, in_g, K, N, mode, first; float scale; unsigned pad; unsigned long long wt_off; };
constexpr int PI_GU = (D / 64) * (2 * FF / 32), PI_DN = (FF / 64) * (D / 32), PI_IN = (D / 64) * (IC / 32), PI_SQ = (D / 64) * (D / 32), PI_KV = (D / 64) * (2 * D / 32);
__device__ const P0Tab P0TAB[9] = {
    {I_F1GU, I_F1N, D, 2 * FF, 1, 0, 1.f, 0u, WS_WGU1},
    {I_WKV, -1, D, 2 * D, 0, PI_GU, 1.f, 0u, WS_WKV},
    {I_F1D, -1, FF, D, 0, PI_GU + PI_KV, 1.f, 0u, WS_WD1},
    {I_WIN, I_MIXN, D, IC, 2, PI_GU + PI_KV + PI_DN, 1.f, 0u, WS_WIN},
    {I_WOUT, -1, D, D, 0, PI_GU + PI_KV + PI_DN + PI_IN, 1.f, 0u, WS_WOUT},
    {I_WQ, I_XAN, D, D, 0, PI_GU + PI_KV + PI_DN + PI_IN + PI_SQ, 0.0625f, 0u, WS_WQ},
    {I_WO, -1, D, D, 0, PI_GU + PI_KV + PI_DN + PI_IN + 2 * PI_SQ, 1.f, 0u, WS_WO},
    {I_F2GU, I_F2N, D, 2 * FF, 1, PI_GU + PI_KV + PI_DN + PI_IN + 3 * PI_SQ, 1.f, 0u, WS_WGU2},
    {I_F2D, -1, FF, D, 0, 2 * PI_GU + PI_KV + PI_DN + PI_IN + 3 * PI_SQ, 1.f, 0u, WS_WD2},
};
constexpr int P0_EARLY = PI_GU + PI_KV, P0_MID = PI_GU + PI_KV + PI_DN + PI_IN + 3 * PI_SQ, P0_GU2 = P0_MID + PI_GU, P0_ALL = P0_GU2 + PI_DN;

__device__ __forceinline__ void p0_items(const Args& a, LAS float* scr, int first, int last, int w, int nw, int lane) {
    unsigned char* ws = a.ws;
    auto desc = [&](int it) -> P0Desc {
        int mi = 0;
#pragma unroll
        for (int j = 1; j < 9; ++j) mi += (it >= P0TAB[j].first) ? 1 : 0;
        const P0Tab t = P0TAB[mi];
        P0Desc d; d.W = a.in[t.in_w]; d.WT = (bf16*)(ws + t.wt_off); d.gain = t.in_g >= 0 ? a.in[t.in_g] : nullptr; d.scale = t.scale; d.K = t.K; d.N = t.N; d.mode = t.mode; d.item = it - t.first;
        return d;
    };
    float va[32], vb[32]; int it = first + w;
    P0Desc da = desc(it < last ? it : first), db = da;
    if (it < last) p0_load(da, va, lane);
    while (it < last) {
        const int n1 = it + nw; if (n1 < last) { db = desc(n1); p0_load(db, vb, lane); }
        p0_store(da, va, scr, lane);
        if (n1 >= last) break;
        const int n2 = n1 + nw; if (n2 < last) { da = desc(n2); p0_load(da, va, lane); }
        p0_store(db, vb, scr, lane);
        it = n2;
    }
}
__device__ __forceinline__ void p0_prologue(const Args& a, LAS unsigned char* lds, int gw, int NGW, int wave, int lane) {
    unsigned char* ws = a.ws;
    LAS float* scr = (LAS float*)(lds + wave * 16384);
    p0_items(a, scr, 0, P0_EARLY, gw, NGW, lane);
    float* ssq = (float*)(ws + WS_SSQ);
    for (int m = gw; m < M; m += 2 * NGW) {
        const int m1 = m + NGW;
        const f32x4* xr0 = (const f32x4*)(a.in[I_X] + (size_t)m * D) + lane; const f32x4* xr1 = (const f32x4*)(a.in[I_X] + (size_t)(m1 < M ? m1 : m) * D) + lane; f32x4 v[4], w4[4]; float s = 0.f, s1 = 0.f;
#pragma unroll
        for (int j = 0; j < 4; ++j) { v[j] = xr0[64 * j]; w4[j] = xr1[64 * j]; }
#pragma unroll
        for (int j = 0; j < 4; ++j) { s += (v[j][0] * v[j][0] + v[j][1] * v[j][1]) + (v[j][2] * v[j][2] + v[j][3] * v[j][3]); s1 += (w4[j][0] * w4[j][0] + w4[j][1] * w4[j][1]) + (w4[j][2] * w4[j][2] + w4[j][3] * w4[j][3]); }
        s = wave_sum(s); s1 = wave_sum(s1); if (lane == 0) { ssq[m] = s; if (m1 < M) ssq[m1] = s1; }
        v2u* o = (v2u*)((bf16*)(ws + WS_XB) + (size_t)m * D) + lane;
#pragma unroll
        for (int j = 0; j < 4; ++j) { v2u w; w.x = pk2(v[j][0], v[j][1]); w.y = pk2(v[j][2], v[j][3]); o[64 * j] = w; }
        if (m1 < M) { v2u* o1 = (v2u*)((bf16*)(ws + WS_XB) + (size_t)m1 * D) + lane;
#pragma unroll
            for (int j = 0; j < 4; ++j) { v2u w; w.x = pk2(w4[j][0], w4[j][1]); w.y = pk2(w4[j][2], w4[j][3]); o1[64 * j] = w; } }
    }
    for (int m = gw; m < NB * NMEM; m += NGW) {
        const f32x4* xr = (const f32x4*)(a.in[I_MEM] + (size_t)m * D) + lane; const f32x4* gr = (const f32x4*)(a.in[I_MEMNORM]) + lane; f32x4 v[4]; float s = 0.f;
#pragma unroll
        for (int j = 0; j < 4; ++j) { v[j] = xr[64 * j]; s += (v[j][0] * v[j][0] + v[j][1] * v[j][1]) + (v[j][2] * v[j][2] + v[j][3] * v[j][3]); }
        s = wave_sum(s); const float rs = rsqrtf(s * (1.f / D) + EPS);
        v2u* o = (v2u*)((bf16*)(ws + WS_MEMN) + (size_t)m * D) + lane;
#pragma unroll
        for (int j = 0; j < 4; ++j) { const f32x4 g = gr[64 * j]; v2u w; w.x = pk2(v[j][0] * rs * g[0], v[j][1] * rs * g[1]); w.y = pk2(v[j][2] * rs * g[2], v[j][3] * rs * g[3]); o[64 * j] = w; }
    }
    for (int i = gw * 64 + lane; i < 4 * M; i += NGW * 64) ssq[M + i] = 0.f;
}

constexpr int GP = 264;
__device__ __forceinline__ void hg_a2_quad(unsigned char* ws, float* Gp, LAS unsigned char* lds, int quad, int tid) {
    const int k = tid & 127, seg = tid >> 7, lane = tid & 63, wave = tid >> 6, l15 = lane & 15, lq = lane >> 4;
    LAS float* segsum = (LAS float*)lds;
    LAS float* dl = (LAS float*)(lds + 2048);
    LAS bf16* KPt = (LAS bf16*)(lds + 2560);
    LAS bf16* Vt = KPt + 128 * GP;
    f32x4 R[8];
#pragma unroll
    for (int kt = 0; kt < 8; ++kt) R[kt] = (f32x4){0.f, 0.f, 0.f, 0.f};
#pragma unroll 1
    for (int gi = 0; gi < 4; ++gi) {
        const int unit = quad * 4 + gi, bh = unit >> 4, g = unit & 15, b = bh >> 2, h = bh & 3, row0 = b * SEQ + g * 256;
        const size_t gofs = (size_t)(row0 + seg * 64) * 512 + h * 128 + k;
        const _Float16* lfp = (const _Float16*)(ws + WS_LF) + gofs; const bf16* vp = (const bf16*)(ws + WS_VV) + gofs;
        float lf[64]; unsigned vq[32];
#pragma unroll
        for (int i = 0; i < 64; ++i) lf[i] = (float)lfp[(size_t)i * 512];
#pragma unroll
        for (int i = 0; i < 32; ++i) vq[i] = (unsigned)vp[(size_t)(2 * i) * 512] | ((unsigned)vp[(size_t)(2 * i + 1) * 512] << 16);
        if (gi > 0) { float* pp = Gp + (size_t)unit * 16384 + (size_t)(wave * 8) * 256 + lane * 4;
#pragma unroll
            for (int kt = 0; kt < 8; ++kt) *(f32x4*)(pp + kt * 256) = R[kt]; }
        float run = 0.f;
#pragma unroll
        for (int i = 0; i < 64; ++i) run += lf[i];
        segsum[seg * 128 + k] = run;
#pragma unroll
        for (int i = 0; i < 8; ++i) *(LAS v4u*)(Vt + k * GP + seg * 64 + 8 * i) = (v4u){vq[4 * i], vq[4 * i + 1], vq[4 * i + 2], vq[4 * i + 3]};
        LBAR();
        const float s0 = segsum[k], s1 = segsum[128 + k], s2 = segsum[256 + k], s3 = segsum[384 + k];
        const float pre = (seg > 0 ? s0 : 0.f) + (seg > 1 ? s1 : 0.f) + (seg > 2 ? s2 : 0.f);
        const float blast = (s0 + s1) + (s2 + s3);
        run = pre;
#pragma unroll
        for (int i8 = 0; i8 < 8; ++i8) { unsigned kp[4];
#pragma unroll
            for (int j = 0; j < 4; ++j) { const float l0 = lf[8 * i8 + 2 * j], l1 = lf[8 * i8 + 2 * j + 1]; run += l0; const float a0 = (1.f - __expf(l0)) * __expf(blast - run); run += l1; const float a1 = (1.f - __expf(l1)) * __expf(blast - run); kp[j] = pk2(a0, a1); }
            *(LAS v4u*)(KPt + k * GP + seg * 64 + 8 * i8) = (v4u){kp[0], kp[1], kp[2], kp[3]}; }
        if (seg == 0) { const float e = __expf(blast); ((float*)(ws + WS_DEC))[unit * 128 + k] = e; dl[k] = e; }
        LBAR();
#pragma unroll
        for (int kt = 0; kt < 8; ++kt) { const f32x4 d = *(const LAS f32x4*)(dl + 16 * kt + 4 * lq); R[kt] = R[kt] * d; }
#pragma unroll
        for (int ss = 0; ss < 8; ++ss) { const bf16x8 y = *(const LAS bf16x8*)(Vt + (16 * wave + l15) * GP + 32 * ss + 8 * lq);
#pragma unroll
            for (int kt = 0; kt < 8; ++kt) { const bf16x8 x = *(const LAS bf16x8*)(KPt + (16 * kt + l15) * GP + 32 * ss + 8 * lq); R[kt] = __builtin_amdgcn_mfma_f32_16x16x32_bf16(x, y, R[kt], 0, 0, 0); } }
        LBAR();
    }
    float* tp = Gp + (size_t)(256 + quad) * 16384 + (size_t)(wave * 8) * 256 + lane * 4;
#pragma unroll
    for (int kt = 0; kt < 8; ++kt) *(f32x4*)(tp + kt * 256) = R[kt];
}
template <int NR>
__device__ __forceinline__ void conv_rows(const Args& a, int r0, int rstride, int lane) {
    unsigned char* ws = a.ws; const int c0 = 8 * lane;
    const bf16* BCp = (const bf16*)(ws + WS_BC); const bf16* CUp = (const bf16*)(ws + WS_CU);
    v4u bq[NR], u0[NR], u1[NR], u2[NR];
#pragma unroll
    for (int i = 0; i < NR; ++i) { const int row = r0 + i * rstride, t = row & (SEQ - 1);
        bq[i] = *(const v4u*)(BCp + (size_t)row * 512 + c0); u0[i] = *(const v4u*)(CUp + (size_t)row * 512 + c0);
        u1[i] = (v4u){0, 0, 0, 0}; u2[i] = (v4u){0, 0, 0, 0};
        if (t >= 1) u1[i] = *(const v4u*)(CUp + (size_t)(row - 1) * 512 + c0);
        if (t >= 2) u2[i] = *(const v4u*)(CUp + (size_t)(row - 2) * 512 + c0); }
    const float* cw = a.in[I_CONVW] + c0; const float* gn = a.in[I_CONVN] + c0;
    const f32x4 w0a = *(const f32x4*)(cw), w0b = *(const f32x4*)(cw + 4), w1a = *(const f32x4*)(cw + 512), w1b = *(const f32x4*)(cw + 516), w2a = *(const f32x4*)(cw + 1024), w2b = *(const f32x4*)(cw + 1028);
    const f32x4 ga = *(const f32x4*)(gn), gb = *(const f32x4*)(gn + 4);
#pragma unroll
    for (int i = 0; i < NR; ++i) { const int row = r0 + i * rstride; float y[8]; float s = 0.f;
#pragma unroll
        for (int j = 0; j < 8; ++j) { const int sh = (j & 1) * 16; const unsigned ub = bq[i][j >> 1], x0 = u0[i][j >> 1], x1 = u1[i][j >> 1], x2 = u2[i][j >> 1];
            const float B = __uint_as_float(((ub >> sh) & 0xffffu) << 16), c_0 = __uint_as_float(((x0 >> sh) & 0xffffu) << 16), c_1 = __uint_as_float(((x1 >> sh) & 0xffffu) << 16), c_2 = __uint_as_float(((x2 >> sh) & 0xffffu) << 16);
            const float k0 = j < 4 ? w0a[j & 3] : w0b[j & 3], k1 = j < 4 ? w1a[j & 3] : w1b[j & 3], k2 = j < 4 ? w2a[j & 3] : w2b[j & 3];
            y[j] = B * (k0 * c_2 + k1 * c_1 + k2 * c_0); s += y[j] * y[j]; }
        s = wave_sum(s); const float rs = rsqrtf(s * (1.f / 512.f) + EPS);
        v4u o; o.x = pk2(y[0] * rs * ga[0], y[1] * rs * ga[1]); o.y = pk2(y[2] * rs * ga[2], y[3] * rs * ga[3]); o.z = pk2(y[4] * rs * gb[0], y[5] * rs * gb[1]); o.w = pk2(y[6] * rs * gb[2], y[7] * rs * gb[3]);
        pg8::st_wt16((bf16*)(ws + WS_MIX) + (size_t)row * 1024 + 512 + c0, o); }
}
__device__ __forceinline__ void hg_c2_unit(const Args& a, const float* Gp, LAS unsigned char* lds, int unit, int tid) {
    unsigned char* ws = a.ws;
    const int bh = unit >> 4, g = unit & 15, b = bh >> 2, h = bh & 3;
    const int k = tid & 127, seg = tid >> 7, lane = tid & 63, wave = tid >> 6, l15 = lane & 15, lq = lane >> 4;
    LAS float* dl = (LAS float*)lds;
    LAS float* segsum = (LAS float*)(lds + 512);
    LAS float* part = (LAS float*)(lds + 2560);
    LAS bf16* QT = (LAS bf16*)(lds + 4096);
    LAS bf16* Q2 = QT + 64 * 136;
    LAS bf16* KT = Q2 + 64 * 136;
    LAS bf16* Vt = KT + 64 * 136;
    LAS bf16* AT = Vt + 128 * 72;
    LAS bf16* KPt = AT + 64 * 72;
    LAS bf16* SL = KPt + 128 * 72;
    f32x4 S[8];
#pragma unroll
    for (int kt = 0; kt < 8; ++kt) S[kt] = (f32x4){0.f, 0.f, 0.f, 0.f};
    {
        LAS float* DGL = (LAS float*)(SL + 128 * 136);
        for (int i = tid; i < 16 * 128; i += NT) DGL[i] = ((const float*)(ws + WS_DEC))[bh * 16 * 128 + i];
        const int q = g >> 2, gi = g & 3;
        const float* tbase = Gp + (size_t)(256 + bh * 4) * 16384 + (size_t)(wave * 8) * 256 + lane * 4;
        f32x4 ta[8], tb[8], tc[8], pg[8];
#pragma unroll
        for (int kt = 0; kt < 8; ++kt) { const f32x4 z = {0.f, 0.f, 0.f, 0.f};
            ta[kt] = q >= 1 ? *(const f32x4*)(tbase + (size_t)(q - 1) * 16384 + kt * 256) : z;
            tb[kt] = q >= 2 ? *(const f32x4*)(tbase + (size_t)(q - 2) * 16384 + kt * 256) : z;
            tc[kt] = q >= 3 ? *(const f32x4*)(tbase + (size_t)(q - 3) * 16384 + kt * 256) : z;
            pg[kt] = gi >= 1 ? *(const f32x4*)(Gp + (size_t)unit * 16384 + (size_t)(wave * 8) * 256 + lane * 4 + kt * 256) : z; }
        LBAR();
#pragma unroll
        for (int kt = 0; kt < 8; ++kt) { const int ko = 16 * kt + 4 * lq;
            auto dgv = [&](int gg) -> f32x4 { return *(const LAS f32x4*)(DGL + gg * 128 + ko); };
            f32x4 sq = ta[kt];
            if (q >= 2) { const f32x4 w1 = dgv(4 * (q - 1)) * dgv(4 * (q - 1) + 1) * dgv(4 * (q - 1) + 2) * dgv(4 * (q - 1) + 3); sq = sq + w1 * tb[kt];
                if (q >= 3) { const f32x4 w2 = w1 * (dgv(4 * (q - 2)) * dgv(4 * (q - 2) + 1) * dgv(4 * (q - 2) + 2) * dgv(4 * (q - 2) + 3)); sq = sq + w2 * tc[kt]; } }
            f32x4 e = {1.f, 1.f, 1.f, 1.f};
            if (gi >= 1) e = e * dgv(4 * q); if (gi >= 2) e = e * dgv(4 * q + 1); if (gi >= 3) e = e * dgv(4 * q + 2);
            S[kt] = e * sq + pg[kt]; }
    }
    _Float16 nlf[16]; bf16 nvv[16], nqq[16];
    {   const size_t gofs = (size_t)(b * SEQ + g * 256 + seg * 16) * 512 + h * 128 + k;
        const _Float16* lfp = (const _Float16*)(ws + WS_LF) + gofs; const bf16* vp = (const bf16*)(ws + WS_VV) + gofs; const bf16* qp = (const bf16*)(ws + WS_QS) + gofs;
#pragma unroll
        for (int i = 0; i < 16; ++i) { nlf[i] = lfp[(size_t)i * 512]; nvv[i] = vp[(size_t)i * 512]; nqq[i] = qp[(size_t)i * 512]; } }
#pragma unroll 1
    for (int cc = 0; cc < 4; ++cc) {
        const int row0 = b * SEQ + (g * 4 + cc) * 64;
        float lf[16], bc[16]; bf16 vv[16], qq[16];
#pragma unroll
        for (int i = 0; i < 16; ++i) { lf[i] = (float)nlf[i]; vv[i] = nvv[i]; qq[i] = nqq[i]; }
#pragma unroll
        for (int kt = 0; kt < 8; ++kt) { v2u w; w.x = pk2(S[kt][0], S[kt][1]); w.y = pk2(S[kt][2], S[kt][3]); *(LAS v2u*)(SL + (16 * wave + l15) * 136 + 16 * kt + 4 * lq) = w; }
        float run = 0.f;
#pragma unroll
        for (int i = 0; i < 16; ++i) { run += lf[i]; bc[i] = run; }
        segsum[seg * 128 + k] = run;
        {   unsigned vq[8];
#pragma unroll
            for (int i = 0; i < 8; ++i) vq[i] = (unsigned)vv[2 * i] | ((unsigned)vv[2 * i + 1] << 16);
            *(LAS v4u*)(Vt + k * 72 + seg * 16) = (v4u){vq[0], vq[1], vq[2], vq[3]}; *(LAS v4u*)(Vt + k * 72 + seg * 16 + 8) = (v4u){vq[4], vq[5], vq[6], vq[7]}; }
        LBAR();
        const float s0 = segsum[k], s1 = segsum[128 + k], s2 = segsum[256 + k], s3 = segsum[384 + k];
        const float pre = (seg > 0 ? s0 : 0.f) + (seg > 1 ? s1 : 0.f) + (seg > 2 ? s2 : 0.f);
        const float br = s0 + s1, blast = (s0 + s1) + (s2 + s3);
        unsigned kp[8];
        const float Ebr = __expf(br), Ebl = __expf(blast - br);
#pragma unroll
        for (int i = 0; i < 16; ++i) { const int s = seg * 16 + i; const float bb = pre + bc[i]; const float q = bf2f(qq[i]); const float kk = 1.f - __expf(lf[i]);
            const float e1 = __expf(fminf(fmaxf(bb - br, -80.f), 80.f)), e3 = __builtin_amdgcn_rcpf(e1), e2 = e1 * Ebr, e4 = e3 * Ebl;
            const unsigned w1 = pk2(q * e1, q * e2), w3 = pk2(kk * e3, kk * e4);
            QT[s * 136 + k] = (bf16)(w1 & 0xffffu); Q2[s * 136 + k] = (bf16)(w1 >> 16); KT[s * 136 + k] = (bf16)(w3 & 0xffffu);
            if (i & 1) kp[i >> 1] |= (w3 & 0xffff0000u); else kp[i >> 1] = w3 >> 16; }
        *(LAS v4u*)(KPt + k * 72 + seg * 16) = (v4u){kp[0], kp[1], kp[2], kp[3]}; *(LAS v4u*)(KPt + k * 72 + seg * 16 + 8) = (v4u){kp[4], kp[5], kp[6], kp[7]};
        if (seg == 0) dl[k] = __expf(blast);
        if (cc < 3) {
            const size_t gofs = (size_t)(row0 + 64 + seg * 16) * 512 + h * 128 + k;
            const _Float16* lfp = (const _Float16*)(ws + WS_LF) + gofs; const bf16* vp = (const bf16*)(ws + WS_VV) + gofs; const bf16* qp = (const bf16*)(ws + WS_QS) + gofs;
#pragma unroll
            for (int i = 0; i < 16; ++i) { nlf[i] = lfp[(size_t)i * 512]; nvv[i] = vp[(size_t)i * 512]; nqq[i] = qp[(size_t)i * 512]; } }
        v2u gsw4[4]; f32x4 gn4[4];
        {   const int tq = 16 * (wave & 3) + l15; const size_t orow_ = (size_t)(row0 + tq);
#pragma unroll
            for (int n = 0; n < 4; ++n) { const int v0 = 64 * (wave >> 2) + 16 * n + 4 * lq; gsw4[n] = *(const v2u*)((const bf16*)(ws + WS_GS) + orow_ * 512 + h * 128 + v0); gn4[n] = *(const f32x4*)(a.in[I_HGN] + v0); } }
        LBAR();
        {
            const int tt = wave >> 1;
#pragma unroll
            for (int si = 0; si < 2; ++si) { const int st = 2 * (wave & 1) + si; f32x4 acc = {0.f, 0.f, 0.f, 0.f};
                if (st <= tt) {
#pragma unroll
                    for (int kk = 0; kk < 4; ++kk) { const bf16x8 x = *(const LAS bf16x8*)(KT + (16 * st + l15) * 136 + 32 * kk + 8 * lq), y = *(const LAS bf16x8*)(QT + (16 * tt + l15) * 136 + 32 * kk + 8 * lq);
                        acc = __builtin_amdgcn_mfma_f32_16x16x32_bf16(x, y, acc, 0, 0, 0); } }
                const int t = 16 * tt + l15, sb = 16 * st + 4 * lq;
#pragma unroll
                for (int r = 0; r < 4; ++r) if (sb + r > t) acc[r] = 0.f;
                v2u w; w.x = pk2(acc[0], acc[1]); w.y = pk2(acc[2], acc[3]); *(LAS v2u*)(AT + t * 72 + sb) = w; }
        }
        LBAR();
        const int tt = wave & 3, vh = wave >> 2; f32x4 acc[4];
#pragma unroll
        for (int n = 0; n < 4; ++n) acc[n] = (f32x4){0.f, 0.f, 0.f, 0.f};
#pragma unroll
        for (int kk = 0; kk < 4; ++kk) { const bf16x8 y = *(const LAS bf16x8*)(Q2 + (16 * tt + l15) * 136 + 32 * kk + 8 * lq);
#pragma unroll
            for (int n = 0; n < 4; ++n) { const bf16x8 x = *(const LAS bf16x8*)(SL + (64 * vh + 16 * n + l15) * 136 + 32 * kk + 8 * lq); acc[n] = __builtin_amdgcn_mfma_f32_16x16x32_bf16(x, y, acc[n], 0, 0, 0); } }
#pragma unroll
        for (int ss = 0; ss < 2; ++ss) { const bf16x8 y = *(const LAS bf16x8*)(AT + (16 * tt + l15) * 72 + 32 * ss + 8 * lq);
#pragma unroll
            for (int n = 0; n < 4; ++n) { const bf16x8 x = *(const LAS bf16x8*)(Vt + (64 * vh + 16 * n + l15) * 72 + 32 * ss + 8 * lq); acc[n] = __builtin_amdgcn_mfma_f32_16x16x32_bf16(x, y, acc[n], 0, 0, 0); } }
        float ssq = 0.f;
#pragma unroll
        for (int n = 0; n < 4; ++n) ssq += (acc[n][0] * acc[n][0] + acc[n][1] * acc[n][1]) + (acc[n][2] * acc[n][2] + acc[n][3] * acc[n][3]);
        ssq += __shfl_xor(ssq, 16); ssq += __shfl_xor(ssq, 32);
        const int t = 16 * tt + l15;
        if (lq == 0) part[vh * 64 + t] = ssq;
#pragma unroll
        for (int kt = 0; kt < 8; ++kt) { const f32x4 d = *(const LAS f32x4*)(dl + 16 * kt + 4 * lq); S[kt] = S[kt] * d;
#pragma unroll
            for (int ss = 0; ss < 2; ++ss) { const bf16x8 x = *(const LAS bf16x8*)(KPt + (16 * kt + l15) * 72 + 32 * ss + 8 * lq), y = *(const LAS bf16x8*)(Vt + (16 * wave + l15) * 72 + 32 * ss + 8 * lq);
                S[kt] = __builtin_amdgcn_mfma_f32_16x16x32_bf16(x, y, S[kt], 0, 0, 0); } }
        LBAR();
        const float rs = rsqrtf((part[t] + part[64 + t]) * (1.f / 128.f) + EPS);
        const size_t orow = (size_t)(row0 + t);
#pragma unroll
        for (int n = 0; n < 4; ++n) { const int v0 = 64 * vh + 16 * n + 4 * lq; const v2u gsw = gsw4[n]; const f32x4 gn = gn4[n];
            const float o0 = acc[n][0] * rs * gn[0] * __uint_as_float(gsw.x << 16), o1 = acc[n][1] * rs * gn[1] * __uint_as_float(gsw.x & 0xffff0000u);
            const float o2 = acc[n][2] * rs * gn[2] * __uint_as_float(gsw.y << 16), o3 = acc[n][3] * rs * gn[3] * __uint_as_float(gsw.y & 0xffff0000u);
            v2u w; w.x = pk2(o0, o1); w.y = pk2(o2, o3); pg8::st_wt8((bf16*)(ws + WS_MIX) + orow * 1024 + h * 128 + v0, w); }
        LBAR();
    }
}
constexpr int XP = 264;
__device__ __forceinline__ void stage_half(const bf16* g, LAS bf16* dst, int tid) {
    v4u t[8];
#pragma unroll
    for (int i = 0; i < 8; ++i) { const int ch = tid + i * NT, r = ch >> 5, cc = ch & 31; t[i] = *(const v4u*)(g + (size_t)r * 1024 + cc * 8); }
#pragma unroll
    for (int i = 0; i < 8; ++i) { const int ch = tid + i * NT, r = ch >> 5, cc = ch & 31; *(LAS v4u*)(dst + r * XP + cc * 8) = t[i]; }
}
__device__ __forceinline__ void xattn_core(unsigned char* ws, LAS unsigned char* lds, int b, int hd, int qb, int tid, const bf16x8 (&qf)[16]) {
    const int lane = tid & 63, wave = tid >> 6, r32 = lane & 31, hh = lane >> 5;
    LAS bf16* L0 = (LAS bf16*)lds; LAS bf16* L1 = L0 + 128 * XP;
    const bf16* Kg = (const bf16*)(ws + WS_KB) + (size_t)(b * 256) * 1024 + hd * 256;
    const bf16* Vg = (const bf16*)(ws + WS_VT) + (size_t)(hd * 256) * 1024 + b * 256;
    stage_half(Kg, L0, tid); stage_half(Kg + (size_t)128 * 1024, L1, tid);
    const int q0 = b * SEQ + qb * 256 + 32 * wave;
    __syncthreads();
    f32x16 sacc[8];
#pragma unroll
    for (int mt = 0; mt < 8; ++mt) {
#pragma unroll
        for (int r = 0; r < 16; ++r) sacc[mt][r] = 0.f;
        const LAS bf16* kp = (mt < 4 ? L0 : L1) + ((mt & 3) * 32 + r32) * XP + 8 * hh;
#pragma unroll
        for (int ds = 0; ds < 16; ++ds) { const bf16x8 kf = *(const LAS bf16x8*)(kp + 16 * ds); sacc[mt] = __builtin_amdgcn_mfma_f32_32x32x16_bf16(kf, qf[ds], sacc[mt], 0, 0, 0); } }
    __syncthreads();
    stage_half(Vg, L0, tid); stage_half(Vg + (size_t)128 * 1024, L1, tid);
    float mx = -3.0e38f;
#pragma unroll
    for (int mt = 0; mt < 8; ++mt)
#pragma unroll
        for (int r = 0; r < 16; ++r) mx = fmaxf(mx, sacc[mt][r]);
    mx = fmaxf(mx, __shfl_xor(mx, 32));
    float sum = 0.f; bf16x8 pf[8][2];
#pragma unroll
    for (int mt = 0; mt < 8; ++mt) {
        float e[16];
#pragma unroll
        for (int r = 0; r < 16; ++r) { e[r] = __expf(sacc[mt][r] - mx); sum += e[r]; }
#pragma unroll
        for (int s = 0; s < 2; ++s) { v4u w; w.x = pk2(e[8 * s], e[8 * s + 1]); w.y = pk2(e[8 * s + 2], e[8 * s + 3]); w.z = pk2(e[8 * s + 4], e[8 * s + 5]); w.w = pk2(e[8 * s + 6], e[8 * s + 7]); pf[mt][s] = __builtin_bit_cast(bf16x8, w); }
    }
    sum += __shfl_xor(sum, 32);
    const float inv = 1.f / sum;
    __syncthreads();
    bf16* op = (bf16*)(ws + WS_O) + (size_t)(q0 + r32) * 1024 + hd * 256 + 4 * hh;
#pragma unroll 1
    for (int dt = 0; dt < 8; ++dt) {
        f32x16 o;
#pragma unroll
        for (int r = 0; r < 16; ++r) o[r] = 0.f;
        const LAS bf16* vpb = (dt < 4 ? L0 : L1) + ((dt & 3) * 32 + r32) * XP + 4 * hh;
#pragma unroll
        for (int mt = 0; mt < 8; ++mt)
#pragma unroll
            for (int s = 0; s < 2; ++s) { const v2u lo = *(const LAS v2u*)(vpb + 32 * mt + 16 * s), hi = *(const LAS v2u*)(vpb + 32 * mt + 16 * s + 8);
                const v4u vw = {lo.x, lo.y, hi.x, hi.y}; o = __builtin_amdgcn_mfma_f32_32x32x16_bf16(__builtin_bit_cast(bf16x8, vw), pf[mt][s], o, 0, 0, 0); }
#pragma unroll
        for (int g = 0; g < 4; ++g) { v2u w; w.x = pk2(o[4 * g] * inv, o[4 * g + 1] * inv); w.y = pk2(o[4 * g + 2] * inv, o[4 * g + 3] * inv); pg8::st_wt8(op + 32 * dt + 8 * g, w); }
    }
    __syncthreads();
}

struct EpiAttn {
    static constexpr bool PERM = false, AFTER_DRAIN = true;
    unsigned char* ws; const float* ssq; unsigned* psync;
    __device__ __forceinline__ void fused(f32x4 (&acc)[2][2][4][2], const pg8::Unit& u, int wr, int wc, int fr, int fq, LAS unsigned char* lds, int wid, int lane) const {
        LAS bf16* QI = (LAS bf16*)lds;
#pragma unroll
        for (int ai = 0; ai < 2; ++ai)
#pragma unroll
            for (int m = 0; m < 4; ++m) { const int rl = ai * 128 + wr * 64 + m * 16 + fr; const float rs = pg8::row_rs(ssq, u.pm * 256 + rl);
#pragma unroll
                for (int bj = 0; bj < 2; ++bj)
#pragma unroll
                    for (int n = 0; n < 2; ++n) { const f32x4 v = acc[ai][bj][m][n] * rs; v2u w; w.x = pk2(v[0], v[1]); w.y = pk2(v[2], v[3]);
                        *(LAS v2u*)(QI + rl * XP + bj * 128 + wc * 32 + n * 16 + 4 * fq) = w; } }
        __syncthreads();
        const int r32 = lane & 31, hh = lane >> 5; bf16x8 qf[16];
#pragma unroll
        for (int ds = 0; ds < 16; ++ds) qf[ds] = *(const LAS bf16x8*)(QI + (32 * wid + r32) * XP + 16 * ds + 8 * hh);
        __syncthreads();
        xattn_core(ws, lds, u.pm >> 4, u.pn, u.pm & 15, wid * 64 + lane, qf);
        if (psync) pg8::panel_sync(psync, u.pm, wid, lane);
    }
};

#define XB_TMO      128
#define XB_XCNT(j)  (256  + 64 * (j))
#define XB_XSUB(j)  (1280 + 64 * (j))
#define XB_XGEN(j)  (2304 + 64 * (j))
#define XB_TOP      3328
#define XB_TOPGEN   3392
#define XCD_BAR_WORDS 3456
#define XB_SPIN_CAP (1u << 18)

__device__ __forceinline__ unsigned xb_ld(unsigned* p)              { return __hip_atomic_load(p, __ATOMIC_RELAXED, __HIP_MEMORY_SCOPE_AGENT); }
__device__ __forceinline__ unsigned xb_add(unsigned* p, unsigned v) { return __hip_atomic_fetch_add(p, v, __ATOMIC_RELAXED, __HIP_MEMORY_SCOPE_AGENT); }
__device__ __forceinline__ unsigned xb_xcc_id() { return (unsigned)__builtin_amdgcn_s_getreg((3 << 11) | 20) & 0xFu; }
#define XB_SPIN(cond, bar) do { unsigned _sp = 0; while (cond) { __builtin_amdgcn_s_sleep(1); \
    if ((++_sp & 255u) == 0u) { if (xb_ld(&(bar)[XB_TMO])) break; if (_sp > XB_SPIN_CAP) { atomicAdd(&(bar)[XB_TMO], 1u); break; } } } } while (0)

struct XcdBarrier {
    unsigned* bar; unsigned x;
    volatile LAS unsigned* st;
};

__device__ __forceinline__ XcdBarrier xcd_barrier_post(unsigned* bar, volatile LAS unsigned* st) {
    XcdBarrier b; b.bar = bar; b.x = xb_xcc_id(); b.st = st;
    if (threadIdx.x == 0) (void)xb_add(&bar[XB_XCNT(b.x)], 1u);
    return b;
}
__device__ __forceinline__ void xcd_barrier_complete(unsigned* bar, unsigned x, unsigned& nloc, unsigned& nx) {
    const unsigned G = gridDim.x * gridDim.y * gridDim.z;
    unsigned sum, cnt, mine, sp = 0u;
    for (;;) {
        sum = 0u; cnt = 0u; mine = 0u;
#pragma unroll
        for (unsigned j = 0; j < 16; ++j) { const unsigned c = xb_ld(&bar[XB_XCNT(j)]); sum += c; cnt += (c > 0u) ? 1u : 0u; mine = (j == x) ? c : mine; }
        if (sum == G) break;
        __builtin_amdgcn_s_sleep(1);
        if ((++sp & 255u) == 0u) { if (xb_ld(&bar[XB_TMO])) break; if (sp > XB_SPIN_CAP) { atomicAdd(&bar[XB_TMO], 1u); break; } }
    }
    nloc = mine > 0u ? mine : 1u; nx = cnt > 0u ? cnt : 1u;
}

__device__ __forceinline__ void xcd_barrier(const XcdBarrier& b) {
    asm volatile("s_waitcnt vmcnt(0)" ::: "memory");
    __syncthreads();
    if (threadIdx.x == 0) {
        unsigned* bar = b.bar;
        __builtin_amdgcn_s_waitcnt(0);
        unsigned nloc = b.st[0], nx = b.st[1];
        if (nloc == 0u) { xcd_barrier_complete(bar, b.x, nloc, nx); b.st[0] = nloc; b.st[1] = nx; }
        const unsigned old = xb_add(&bar[XB_XSUB(b.x)], 1u);
        const unsigned gen = old / nloc;
        if (old + 1u == (gen + 1u) * nloc) {
            __builtin_amdgcn_fence(__ATOMIC_RELEASE, "agent");
            asm volatile("s_waitcnt vmcnt(0)" ::: "memory");
            const unsigned og = xb_add(&bar[XB_TOP], 1u);
            const unsigned tg = og / nx;
            if (og + 1u == (tg + 1u) * nx) xb_add(&bar[XB_TOPGEN], 1u);
            else XB_SPIN(xb_ld(&bar[XB_TOPGEN]) == tg, bar);
            __builtin_amdgcn_fence(__ATOMIC_ACQUIRE, "agent");
            xb_add(&bar[XB_XGEN(b.x)], 1u);
            asm volatile("s_waitcnt vmcnt(0)" ::: "memory");
        } else {
            XB_SPIN(xb_ld(&bar[XB_XGEN(b.x)]) == gen, bar);
            __builtin_amdgcn_fence(__ATOMIC_ACQUIRE, "agent");
            asm volatile("s_waitcnt vmcnt(0)" ::: "memory");
        }
    }
    __syncthreads();
}

#ifndef FLAT_BAR
#define FLAT_BAR 0
#endif
__device__ __forceinline__ void flat_barrier(unsigned* cnt, unsigned& gen, unsigned G) {
    asm volatile("s_waitcnt vmcnt(0)" ::: "memory");
    __syncthreads();
    if (threadIdx.x == 0) {
        __builtin_amdgcn_fence(__ATOMIC_RELEASE, "agent");
        asm volatile("s_waitcnt vmcnt(0)" ::: "memory");
        __hip_atomic_fetch_add(cnt + 64 * (blockIdx.x & 7u), 1u, __ATOMIC_RELAXED, __HIP_MEMORY_SCOPE_AGENT);
        const unsigned target = (gen + 1u) * G; unsigned sp = 0;
        for (;;) { unsigned sum = 0;
#pragma unroll
            for (int j = 0; j < 8; ++j) sum += __hip_atomic_load(cnt + 64 * j, __ATOMIC_RELAXED, __HIP_MEMORY_SCOPE_AGENT);
            if (sum >= target) break;
            __builtin_amdgcn_s_sleep(1);
            if (++sp > (1u << 20)) break; }
        __builtin_amdgcn_fence(__ATOMIC_ACQUIRE, "agent");
        asm volatile("s_waitcnt vmcnt(0)" ::: "memory");
    }
    ++gen;
    __syncthreads();
}

constexpr int N_PHASES = 14;
#ifndef DUPMASK
#define DUPMASK 0
#endif
#define NREP(k) (1 + ((DUPMASK >> (k)) & 1))
__global__ void __launch_bounds__(NT, 2) hymba_fwd(Args args) {
    extern __shared__ __attribute__((aligned(16))) unsigned char lds_raw[];
    LAS unsigned char* lds = (LAS unsigned char*)lds_raw;
    const int tid = threadIdx.x, lane = tid & 63, wave = __builtin_amdgcn_readfirstlane(tid >> 6);
    const int G = gridDim.x, bx = blockIdx.x;
    const int vcu = (G % 8 == 0) ? (bx % 8) * (G / 8) + bx / 8 : bx;
    const int gw = vcu * NWAVES + wave, NGW = G * NWAVES;
    unsigned char* ws = args.ws;
    float* ssq = (float*)(ws + WS_SSQ);
    const int lo = args.ph_lo, hi = args.ph_hi;
#define IN(k) (lo <= (k) && (k) < hi)
#if FLAT_BAR
    unsigned fgen = 0;
#define SEAM(k) do { if (IN(k) && IN((k) + 1)) flat_barrier((unsigned*)(ws + WS_BAR + 65536), fgen, (unsigned)G); } while (0)
#else
#define SEAM(k) do { if (IN(k) && IN((k) + 1)) xcd_barrier(xbar); } while (0)
#endif
    bf16* XB = (bf16*)(ws + WS_XB); bf16* Hb = (bf16*)(ws + WS_H);
    if (lo < 0) cg::this_grid().sync();
    volatile LAS unsigned* MISC = (volatile LAS unsigned*)(lds + MISC_OFF);
    if (tid < 16) MISC[tid] = 0u;
    __syncthreads();
    XcdBarrier xbar = xcd_barrier_post((unsigned*)(ws + WS_BAR), MISC);

    if (IN(0)) { for (int rep = 0; rep < NREP(0); ++rep) p0_prologue(args, lds, gw, NGW, wave, lane); }
    SEAM(0);
    if (IN(1)) _Pragma("unroll") for (int rep = 0; rep < NREP(1); ++rep) {
        { pg8::Gemm g{XB, (const bf16*)(ws + WS_WGU1), M, 2 * FF, D}; pg8::StaticOrder S; S.init(M, 2 * FF, G, bx);
          pg8::EpiSwiglu E{Hb, FF, ssq}; pg8::gemm_phase<pg8::EpiSwiglu, pg8::StaticOrder, true, true>(lds, g, S, E); }
        { pg8::Gemm g{(const bf16*)(ws + WS_MEMN), (const bf16*)(ws + WS_WKV), NB * NMEM, D, D}; pg8::StaticOrder S; S.init(NB * NMEM, D, G, (bx + G - 128) % G);
          pg8::EpiScale E{(bf16*)(ws + WS_KB), D, nullptr}; pg8::gemm_phase<pg8::EpiScale, pg8::StaticOrder, true, true>(lds, g, S, E); }
        { pg8::Gemm g{(const bf16*)(ws + WS_WKV) + (size_t)D * D, (const bf16*)(ws + WS_MEMN), D, NB * NMEM, D}; pg8::StaticOrder S; S.init(D, NB * NMEM, G, (bx + G - 144) % G);
          pg8::EpiScale E{(bf16*)(ws + WS_VT), NB * NMEM, nullptr}; pg8::gemm_phase<pg8::EpiScale, pg8::StaticOrder, true, true>(lds, g, S, E); }
        if (G == 256 && bx >= 160) p0_items(args, (LAS float*)(lds + wave * 16384), P0_EARLY, P0_MID, (bx - 160) * NWAVES + wave, 96 * NWAVES, lane);
        else if (G != 256) p0_items(args, (LAS float*)(lds + wave * 16384), P0_EARLY, P0_MID, bx * NWAVES + wave, NGW, lane);
    }
    SEAM(1);
    if (IN(2)) {
        pg8::Gemm g{Hb, (const bf16*)(ws + WS_WD1), M, D, FF}; pg8::StaticOrder S; S.init(M, D, G, bx);
        pg8::EpiResid E{nullptr  , XB, ssq + M, 0.5f, nullptr}; pg8::gemm_phase<pg8::EpiResid, pg8::StaticOrder, false, true>(lds, g, S, E);
    }
    SEAM(2);
    if (IN(3)) _Pragma("unroll") for (int rep = 0; rep < NREP(3); ++rep) {
        pg8::Gemm g{XB, (const bf16*)(ws + WS_WIN), M, 2048, D}; pg8::StaticOrder S; S.init(M, 2048, G, bx);
        pg8::EpiWin E{(bf16*)(ws + WS_QS), (bf16*)(ws + WS_VV), (bf16*)(ws + WS_GS), (bf16*)(ws + WS_BC), (bf16*)(ws + WS_CU), (_Float16*)(ws + WS_LF), ssq + M, args.in[I_LB], 0};
        pg8::gemm_phase<pg8::EpiWin, pg8::StaticOrder, true, true>(lds, g, S, E);
    }
    SEAM(3);
    if (IN(4)) _Pragma("unroll") for (int rep = 0; rep < NREP(4); ++rep) {
        const int GA = (G * 3) / 4;
        if (bx < GA) {
            pg8::Gemm g{XB, (const bf16*)(ws + WS_WIN) + (size_t)2048 * D, M, 1536, D}; pg8::StaticOrder S; S.init(M, 1536, GA, bx);
            pg8::EpiWin E{(bf16*)(ws + WS_QS), (bf16*)(ws + WS_VV), (bf16*)(ws + WS_GS), (bf16*)(ws + WS_BC), (bf16*)(ws + WS_CU), (_Float16*)(ws + WS_LF), ssq + M, args.in[I_LB], 8};
            pg8::gemm_phase<pg8::EpiWin, pg8::StaticOrder, true, true>(lds, g, S, E);
        } else {
            for (int qd = bx - GA; qd < 64; qd += G - GA) hg_a2_quad(ws, args.out, lds, qd, tid);
        }
    }
    if (IN(4)) p0_items(args, (LAS float*)(lds + wave * 16384), P0_MID, P0_GU2, gw, NGW, lane);
    SEAM(4);
    if (IN(5)) _Pragma("unroll") for (int rep = 0; rep < NREP(5); ++rep) {
        if (M % (4 * NGW) == 0) { for (int r = gw; r < M; r += 4 * NGW) conv_rows<4>(args, r, NGW, lane); } else { for (int r = gw; r < M; r += NGW) conv_rows<1>(args, r, NGW, lane); }
        for (int u = vcu; u < 256; u += G) hg_c2_unit(args, args.out, lds, u, tid);
    }
    SEAM(5);
    if (IN(7)) {
        pg8::Gemm g{(const bf16*)(ws + WS_MIX), (const bf16*)(ws + WS_WOUT), M, D, D}; pg8::StaticOrder S; S.init(M, D, G, bx);
        pg8::EpiResid E{nullptr, XB, ssq + 2 * M, 1.f, nullptr}; pg8::gemm_phase<pg8::EpiResid, pg8::StaticOrder, false, true>(lds, g, S, E);
    }
    SEAM(7);
    if (IN(8)) _Pragma("unroll") for (int rep = 0; rep < NREP(8); ++rep) {
        pg8::Gemm g{XB, (const bf16*)(ws + WS_WQ), M, D, D}; pg8::StaticOrder S; S.init(M, D, G, bx);
        EpiAttn E{ws, ssq + 2 * M, nullptr}; pg8::gemm_phase<EpiAttn, pg8::StaticOrder, false, true>(lds, g, S, E);
    }
    SEAM(8);
    if (IN(10)) {
        pg8::Gemm g{(const bf16*)(ws + WS_O), (const bf16*)(ws + WS_WO), M, D, D}; pg8::StaticOrder S; S.init(M, D, G, bx);
        pg8::EpiResid E{nullptr, XB, ssq + 3 * M, 1.f, nullptr}; pg8::gemm_phase<pg8::EpiResid, pg8::StaticOrder, false, true>(lds, g, S, E);
    }
    SEAM(10);
    if (IN(11)) _Pragma("unroll") for (int rep = 0; rep < NREP(11); ++rep) {
        pg8::Gemm g{XB, (const bf16*)(ws + WS_WGU2), M, 2 * FF, D};
        pg8::EpiSwiglu E{Hb, FF, ssq + 3 * M};
        if (G == 256) { pg8::SemiDynOrder S; S.init(M, 2 * FF, G, bx); S.q = (unsigned*)(ws + WS_CNT + 49152); S.slot = (LAS unsigned*)(lds + LDS_BYTES - 128);
            pg8::gemm_phase<pg8::EpiSwiglu, pg8::SemiDynOrder, true, true>(lds, g, S, E);
            p0_items(args, (LAS float*)(lds + wave * 16384), P0_GU2, P0_ALL, gw, NGW, lane); }
        else { pg8::StaticOrder S; S.init(M, 2 * FF, G, bx); pg8::gemm_phase<pg8::EpiSwiglu, pg8::StaticOrder, true, true>(lds, g, S, E); }
        if (G != 256) p0_items(args, (LAS float*)(lds + wave * 16384), P0_GU2, P0_ALL, bx * NWAVES + wave, NGW, lane);
    }
    SEAM(11);
    if (IN(12)) {
        pg8::Gemm g{Hb, (const bf16*)(ws + WS_WD2), M, D, FF}; pg8::StaticOrder S; S.init(M, D, G, bx);
        pg8::EpiFinal E{XB, args.out, ssq + 4 * M, (unsigned*)(ws + WS_CNT), args.in[I_FINN], 0.5f}; pg8::gemm_phase<pg8::EpiFinal, pg8::StaticOrder, false, true>(lds, g, S, E);
    }
#undef IN
#undef SEAM
}

#ifndef MK_N_LAUNCHES
#define MK_N_LAUNCHES 1
#endif
extern "C" void kernel_launch(void* const* d_in, const int* in_sizes, int n_in, void* d_out, int out_size, void* d_ws, size_t ws_size, hipStream_t stream) {
    static int grid = 0;
    if (grid == 0) {
        if (n_in != 21 || out_size != M * D || ws_size < WS_END) { fprintf(stderr, "kernel_launch: unexpected problem (n_in %d out %d ws %zu)\n", n_in, out_size, ws_size); grid = -1; return; }
        int dev = 0, cus = 0, per_cu = 0;
        hipGetDevice(&dev); hipDeviceGetAttribute(&cus, hipDeviceAttributeMultiprocessorCount, dev);
        if (hipFuncSetAttribute((const void*)hymba_fwd, hipFuncAttributeMaxDynamicSharedMemorySize, LDS_BYTES) != hipSuccess) { fprintf(stderr, "kernel_launch: hipFuncSetAttribute failed\n"); grid = -1; return; }
        hipOccupancyMaxActiveBlocksPerMultiprocessor(&per_cu, (const void*)hymba_fwd, NT, LDS_BYTES);
        (void)hipGetLastError();
        if (per_cu < 1) per_cu = 1;
        grid = cus * 1;
        if (grid <= 0) grid = 256;
    }
    if (grid < 0) return;
    Args a{};
    for (int i = 0; i < 21; ++i) a.in[i] = (const float*)d_in[i];
    a.out = (float*)d_out; a.ws = (unsigned char*)d_ws;
#if MK_N_LAUNCHES == 1
    if (hipMemsetAsync((char*)d_ws + WS_BAR, 0, BAR_BYTES, stream) != hipSuccess) { fprintf(stderr, "kernel_launch: memset failed\n"); return; }
    a.ph_lo = 0; a.ph_hi = N_PHASES;
    void* kargs[] = {&a};
    hipError_t e = hipLaunchCooperativeKernel((const void*)hymba_fwd, dim3(grid), dim3(NT), kargs, LDS_BYTES, stream);
    if (e != hipSuccess) fprintf(stderr, "cooperative launch failed: %s (grid %d)\n", hipGetErrorString(e), grid);
#else
    for (int p = 0; p < N_PHASES; ++p) { a.ph_lo = p; a.ph_hi = p + 1; hipLaunchKernelGGL(hymba_fwd, dim3(grid), dim3(NT), LDS_BYTES, stream, a); }
#endif
}
```

```cpp
#include <hip/hip_runtime.h>
#include <hip/hip_cooperative_groups.h>
#include <cstdio>
#include <cstdint>
namespace cg = cooperative_groups;
namespace pg8 {
#define PG8_LAS __attribute__((address_space(3)))
typedef unsigned short bf16_t;
typedef short bf16x8 __attribute__((ext_vector_type(8)));
typedef float f32x4 __attribute__((ext_vector_type(4)));
typedef unsigned u32x4 __attribute__((ext_vector_type(4)));
constexpr int BM = 256, BK = 64, HALF = 128, HTB = HALF * BK * 2  , STAGE_BYTES = 8 * HTB, NXCD = 8, WGM = 8;

__host__ __device__ __forceinline__ int lds_byte(int r, int c) { const int st = (r >> 4) * 2 + (c >> 5), rr = r & 15, cc = c & 31, ob = rr * 64 + cc * 2; return st * 1024 + (ob ^ (((ob >> 9) & 1) << 5)); }
__host__ __device__ __forceinline__ void stage_rc(int b, int& R, int& C) { const int st = b / 1024, sb = b % 1024, swz = sb ^ (((sb >> 9) & 1) << 5); R = (st >> 1) * 16 + swz / 64; C = (st & 1) * 32 + (swz % 64) / 2; }
__host__ __device__ __forceinline__ int perm32(int rho) { const int n = rho >> 4, i = rho & 15; return 8 * (i >> 2) + 4 * n + (i & 3); }

struct Unit { int pm, pn; };
struct Gemm { const bf16_t* A; const bf16_t* Bt; int M, N, K; };

struct StaticOrder {
    int nM, nN, nwg, G, c;
    __host__ __device__ void init(int M, int N, int G_, int c_) { nM = M / BM; nN = N / BM; nwg = nM * nN; G = G_; c = c_; }
    __host__ __device__ bool next(int i, Unit& u) const {
        const long L = (long)i * G + c; if (L >= nwg) return false;
        int wgid = (int)L; { const int q = nwg / NXCD, r = nwg % NXCD, xcd = wgid % NXCD, off = wgid / NXCD; wgid = (xcd < r ? xcd * (q + 1) : r * (q + 1) + (xcd - r) * q) + off; }
        const int nig = WGM * nN, gid = wgid / nig, fm = gid * WGM, gsz = (nM - fm) < WGM ? (nM - fm) : WGM;
        u.pm = fm + ((wgid % nig) % gsz); u.pn = (wgid % nig) / gsz; return true;
    }
    __device__ __forceinline__ void a_ready(const Unit&) const {}
    __device__ __forceinline__ void done(const Unit&) const {}
};

typedef float cvf32x2_t __attribute__((ext_vector_type(2))); typedef __bf16 cvbf16x2_t __attribute__((ext_vector_type(2)));
__device__ __forceinline__ unsigned cvt_pk_bf16(float lo, float hi) { cvf32x2_t v = {lo, hi}; cvbf16x2_t b = __builtin_convertvector(v, cvbf16x2_t); return __builtin_bit_cast(unsigned, b); }
typedef float f32x2 __attribute__((ext_vector_type(2)));
typedef unsigned wt_u32x2 __attribute__((ext_vector_type(2)));
#ifndef WT_STORES
#define WT_STORES 0
#endif
__device__ __forceinline__ void st_wt16(void* p, u32x4 v) {
#if WT_STORES
    asm volatile("global_store_dwordx4 %0, %1, off sc1\n\ts_nop 1" :: "v"(p), "v"(v) : "memory");
#else
    *(u32x4*)p = v;
#endif
}
__device__ __forceinline__ void st_wt8(void* p, wt_u32x2 v) {
#if WT_STORES && 0
    asm volatile("global_store_dwordx2 %0, %1, off sc1\n\ts_nop 1" :: "v"(p), "v"(v) : "memory");
#else
    *(wt_u32x2*)p = v;
#endif
}
template <class Epi, class Sched, bool ALIGN_EPI = false, bool SP2 = false>
__device__ __forceinline__ void gemm_phase(PG8_LAS unsigned char* lds, const Gemm g, const Sched& S, const Epi& E) {
    const int tid = threadIdx.x, wid = __builtin_amdgcn_readfirstlane(tid >> 6), lane = tid & 63, wr = wid >> 2, wc = wid & 3, fr = lane & 15, fq = lane >> 4;
    const int K = g.K, nt = K / BK;
    unsigned voffA[2], voffB[2];
#pragma unroll
    for (int i = 0; i < 2; ++i) { int R, C; stage_rc(tid * 16 + i * 8192, R, C); const int Rb = Epi::PERM ? ((R & ~31) + perm32(R & 31)) : R;
        voffA[i] = (unsigned)(R * K + C) * 2u; voffB[i] = (unsigned)(Rb * K + C) * 2u; }
    const size_t kstep = (size_t)(BK * 2);
    const size_t hstep = (size_t)HALF * K * 2;
    const size_t tstep = 2 * hstep;
    const unsigned ldsw = (unsigned)wid * 1024u;
    const int aoff = lds_byte(wr * 64 + fr, fq * 8), boff = lds_byte(wc * 32 + fr, fq * 8);
#define PG8_SA(b, h) (((b) * 2 + (h)) * HTB)
#define PG8_SB(b, h) ((4 + (b) * 2 + (h)) * HTB)
#define PG8_STAGE(bufoff, gbase, voff) do { _Pragma("unroll") for (int _i = 0; _i < 2; ++_i) \
        __builtin_amdgcn_global_load_lds((const unsigned*)((const char*)(gbase) + (voff)[_i]), (PG8_LAS unsigned*)(lds + (bufoff) + ldsw + _i * 8192), 16, 0, 0); } while (0)
#define PG8_LDA(dst, b, h) do { _Pragma("unroll") for (int m = 0; m < 4; ++m) _Pragma("unroll") for (int k = 0; k < 2; ++k) dst[m][k] = *(const PG8_LAS bf16x8*)(lds + PG8_SA(b, h) + aoff + m * 2048 + k * 1024); } while (0)
#define PG8_LDB(dst, b, h) do { _Pragma("unroll") for (int n = 0; n < 2; ++n) _Pragma("unroll") for (int k = 0; k < 2; ++k) dst[n][k] = *(const PG8_LAS bf16x8*)(lds + PG8_SB(b, h) + boff + n * 2048 + k * 1024); } while (0)
#define PG8_MMA(ai, bj, At, Bt) do { __builtin_amdgcn_s_setprio(1); _Pragma("unroll") for (int m = 0; m < 4; ++m) _Pragma("unroll") for (int n = 0; n < 2; ++n) _Pragma("unroll") for (int k = 0; k < 2; ++k) \
        acc[ai][bj][m][n] = __builtin_amdgcn_mfma_f32_16x16x32_bf16(Bt[n][k], At[m][k], acc[ai][bj][m][n], 0, 0, 0); __builtin_amdgcn_s_setprio(0); } while (0)
#define PG8_WAIT_V(n) asm volatile("s_waitcnt vmcnt(" #n ")" ::: "memory")
#define PG8_WAIT_L(n) asm volatile("s_waitcnt lgkmcnt(" #n ")" ::: "memory")
#define PG8_BAR __builtin_amdgcn_s_barrier()
#define PG8_SCHED __builtin_amdgcn_sched_barrier(0)
    Unit cur, nxt; int ui = 0;
    if (!S.next(0, cur)) return;
    f32x4 acc[2][2][4][2];
#pragma unroll
    for (int a = 0; a < 2; ++a)
#pragma unroll
        for (int b = 0; b < 2; ++b)
#pragma unroll
            for (int m = 0; m < 4; ++m)
#pragma unroll
                for (int n = 0; n < 2; ++n) acc[a][b][m][n] = (f32x4){0.f, 0.f, 0.f, 0.f};
    bf16x8 At[4][2], B0[2][2], B1[2][2];
    const char* cA = (const char*)g.A + (size_t)cur.pm * tstep; const char* cB = (const char*)g.Bt + (size_t)cur.pn * tstep;
    S.a_ready(cur);
    if constexpr (SP2) {
        PG8_STAGE(PG8_SB(0, 0), cB, voffB); PG8_STAGE(PG8_SB(0, 1), cB + hstep, voffB); PG8_STAGE(PG8_SA(0, 0), cA, voffA); PG8_STAGE(PG8_SA(0, 1), cA + hstep, voffA);
        if (wr == 1) PG8_BAR;
        PG8_WAIT_V(2); PG8_BAR;
        PG8_STAGE(PG8_SB(1, 0), cB + kstep, voffB); PG8_STAGE(PG8_SA(1, 0), cA + kstep, voffA); PG8_STAGE(PG8_SB(1, 1), cB + hstep + kstep, voffB);
        PG8_WAIT_V(6); PG8_BAR;
    } else {
        PG8_STAGE(PG8_SB(0, 0), cB, voffB); PG8_STAGE(PG8_SA(0, 0), cA, voffA); PG8_STAGE(PG8_SB(0, 1), cB + hstep, voffB); PG8_STAGE(PG8_SA(0, 1), cA + hstep, voffA);
        if (wr == 1) PG8_BAR;
        PG8_WAIT_V(4); PG8_BAR;
        PG8_STAGE(PG8_SB(1, 0), cB + kstep, voffB); PG8_STAGE(PG8_SA(1, 0), cA + kstep, voffA); PG8_STAGE(PG8_SB(1, 1), cB + hstep + kstep, voffB);
        PG8_WAIT_V(6); PG8_BAR;
    }
    for (;;) {
        const bool has_next = S.next(ui + 1, nxt);
        const char* nA = has_next ? (const char*)g.A + (size_t)nxt.pm * tstep : cA; const char* nB = has_next ? (const char*)g.Bt + (size_t)nxt.pn * tstep : cB;
        for (int t = 0; t < nt; t += 2) {
            const bool last = (t == nt - 2);
            const char* a1 = cA + (size_t)(t + 1) * kstep;
            const char* a2 = last ? nA : cA + (size_t)(t + 2) * kstep; const char* b2 = last ? nB : cB + (size_t)(t + 2) * kstep;
            const char* a3 = a2 + kstep; const char* b3 = b2 + kstep;
            if (last && has_next) S.a_ready(nxt);
            if constexpr (SP2) {
            PG8_LDB(B0, 0, 0); PG8_LDB(B1, 0, 1); PG8_SCHED; PG8_LDA(At, 0, 0); PG8_STAGE(PG8_SA(1, 1), a1 + hstep, voffA);
            PG8_WAIT_V(8); PG8_WAIT_L(0); PG8_BAR; PG8_MMA(0, 0, At, B0); PG8_MMA(0, 1, At, B1); PG8_BAR; PG8_SCHED;
            PG8_LDA(At, 0, 1); PG8_STAGE(PG8_SB(0, 0), b2, voffB); PG8_STAGE(PG8_SB(0, 1), b2 + hstep, voffB); PG8_STAGE(PG8_SA(0, 0), a2, voffA);
            PG8_WAIT_V(8); PG8_WAIT_L(0); PG8_BAR; PG8_MMA(1, 0, At, B0); PG8_MMA(1, 1, At, B1); PG8_BAR; PG8_SCHED;
            PG8_LDB(B0, 1, 0); PG8_LDB(B1, 1, 1); PG8_SCHED; PG8_LDA(At, 1, 0); PG8_STAGE(PG8_SA(0, 1), a2 + hstep, voffA);
            PG8_WAIT_V(8); PG8_WAIT_L(0); PG8_BAR; PG8_MMA(0, 0, At, B0); PG8_MMA(0, 1, At, B1); PG8_BAR; PG8_SCHED;
            PG8_LDA(At, 1, 1); PG8_STAGE(PG8_SB(1, 0), b3, voffB); PG8_STAGE(PG8_SB(1, 1), b3 + hstep, voffB); PG8_STAGE(PG8_SA(1, 0), a3, voffA);
            PG8_WAIT_V(8); PG8_WAIT_L(0); PG8_BAR; PG8_MMA(1, 0, At, B0); PG8_MMA(1, 1, At, B1); PG8_BAR; PG8_SCHED;
            } else {
            PG8_LDB(B0, 0, 0); PG8_SCHED; PG8_LDA(At, 0, 0); PG8_STAGE(PG8_SA(1, 1), a1 + hstep, voffA);
            PG8_WAIT_L(8); PG8_BAR; PG8_WAIT_L(0); PG8_MMA(0, 0, At, B0); PG8_BAR; PG8_SCHED;
            PG8_LDB(B1, 0, 1); PG8_STAGE(PG8_SB(0, 0), b2, voffB);
            PG8_BAR; PG8_WAIT_L(0); PG8_MMA(0, 1, At, B1); PG8_BAR;
            PG8_LDA(At, 0, 1); PG8_STAGE(PG8_SA(0, 0), a2, voffA);
            PG8_BAR; PG8_WAIT_L(0); PG8_MMA(1, 0, At, B0); PG8_BAR; PG8_SCHED;
            PG8_STAGE(PG8_SB(0, 1), b2 + hstep, voffB);
            PG8_WAIT_V(6); PG8_BAR; PG8_MMA(1, 1, At, B1); PG8_BAR;
            PG8_LDB(B0, 1, 0); PG8_SCHED; PG8_LDA(At, 1, 0); PG8_STAGE(PG8_SA(0, 1), a2 + hstep, voffA);
            PG8_WAIT_L(8); PG8_BAR; PG8_WAIT_L(0); PG8_MMA(0, 0, At, B0); PG8_BAR; PG8_SCHED;
            PG8_LDB(B1, 1, 1); PG8_STAGE(PG8_SB(1, 0), b3, voffB);
            PG8_BAR; PG8_WAIT_L(0); PG8_MMA(0, 1, At, B1); PG8_BAR;
            PG8_LDA(At, 1, 1); PG8_STAGE(PG8_SA(1, 0), a3, voffA);
            PG8_BAR; PG8_WAIT_L(0); PG8_MMA(1, 0, At, B0); PG8_BAR; PG8_SCHED;
            PG8_STAGE(PG8_SB(1, 1), b3 + hstep, voffB);
            PG8_WAIT_V(6); PG8_BAR; PG8_MMA(1, 1, At, B1); PG8_BAR;
            }
        }
        if constexpr (ALIGN_EPI) { if (wr == 0) PG8_BAR; }
        if constexpr (!Epi::AFTER_DRAIN) { E(acc, cur, wr, wc, fr, fq); S.done(cur); }
        if (!has_next) break;
#pragma unroll
        for (int a = 0; a < 2; ++a)
#pragma unroll
            for (int b = 0; b < 2; ++b)
#pragma unroll
                for (int m = 0; m < 4; ++m)
#pragma unroll
                    for (int n = 0; n < 2; ++n) acc[a][b][m][n] = (f32x4){0.f, 0.f, 0.f, 0.f};
        cur = nxt; cA = nA; cB = nB; ++ui;
        if constexpr (ALIGN_EPI) { if (wr == 1) PG8_BAR; }
    }
    PG8_WAIT_V(0);
    if constexpr (!ALIGN_EPI) { if (wr == 0) PG8_BAR; }
    PG8_BAR;
    if constexpr (Epi::AFTER_DRAIN) { E.fused(acc, cur, wr, wc, fr, fq, lds, wid, lane); S.done(cur); }
#undef PG8_SA
#undef PG8_SB
#undef PG8_STAGE
#undef PG8_LDA
#undef PG8_LDB
#undef PG8_MMA
#undef PG8_WAIT_V
#undef PG8_WAIT_L
#undef PG8_BAR
#undef PG8_SCHED
}
}
namespace pg8 {
typedef unsigned u32x2 __attribute__((ext_vector_type(2)));
typedef _Float16 f16x4 __attribute__((ext_vector_type(4)));
constexpr float RMS_EPS = 1e-6f;
__device__ __forceinline__ float fsigm(float x) { return __builtin_amdgcn_rcpf(1.f + __expf(-x)); }
__device__ __forceinline__ float fsilu(float x) { return x * fsigm(x); }
__device__ __forceinline__ float row_rs(const float* ssq, int row) { return ssq ? rsqrtf(ssq[row] * (1.f / 1024.f) + RMS_EPS) : 1.f; }

struct EpiSwiglu {
    static constexpr bool PERM = true, AFTER_DRAIN = false;
    bf16_t* H; int ldh; const float* ssq;
    __device__ __forceinline__ void operator()(const f32x4 (&acc)[2][2][4][2], const Unit& u, int wr, int wc, int fr, int fq) const {
        const int row0 = u.pm * BM + wr * 64 + fr, col0 = u.pn * HALF + wc * 32 + 8 * fq;
#pragma unroll
        for (int ai = 0; ai < 2; ++ai)
#pragma unroll
            for (int m = 0; m < 4; ++m) { const int row = row0 + ai * HALF + m * 16; const float rs = row_rs(ssq, row);
                u32x4 w; unsigned pk[4];
#pragma unroll
                for (int n = 0; n < 2; ++n) { const f32x4 g = acc[ai][0][m][n] * rs, up = acc[ai][1][m][n] * rs;
                    pk[2 * n] = cvt_pk_bf16(fsilu(g[0]) * up[0], fsilu(g[1]) * up[1]); pk[2 * n + 1] = cvt_pk_bf16(fsilu(g[2]) * up[2], fsilu(g[3]) * up[3]); }
                w.x = pk[0]; w.y = pk[1]; w.z = pk[2]; w.w = pk[3];
                st_wt16(H + (size_t)row * ldh + col0, w); }
    }
};
struct EpiScale {
    static constexpr bool PERM = true, AFTER_DRAIN = false;
    bf16_t* O; int ldc; const float* ssq;
    __device__ __forceinline__ void operator()(const f32x4 (&acc)[2][2][4][2], const Unit& u, int wr, int wc, int fr, int fq) const {
        const int row0 = u.pm * BM + wr * 64 + fr, col0 = u.pn * BM + wc * 32 + 8 * fq;
#pragma unroll
        for (int ai = 0; ai < 2; ++ai)
#pragma unroll
            for (int m = 0; m < 4; ++m) { const int row = row0 + ai * HALF + m * 16; const float rs = row_rs(ssq, row);
#pragma unroll
                for (int bj = 0; bj < 2; ++bj) { const f32x4 v0 = acc[ai][bj][m][0] * rs, v1 = acc[ai][bj][m][1] * rs; u32x4 w;
                    w.x = cvt_pk_bf16(v0[0], v0[1]); w.y = cvt_pk_bf16(v0[2], v0[3]); w.z = cvt_pk_bf16(v1[0], v1[1]); w.w = cvt_pk_bf16(v1[2], v1[3]);
                    st_wt16(O + (size_t)row * ldc + col0 + bj * HALF, w); } }
    }
};
__device__ __forceinline__ void panel_sync(unsigned* cnt, int pm, int wid, int lane) {
    asm volatile("s_waitcnt vmcnt(0) lgkmcnt(0)" ::: "memory"); __builtin_amdgcn_s_barrier(); asm volatile("" ::: "memory");
    if (wid == 0) {
        if (lane == 0) { __builtin_amdgcn_fence(__ATOMIC_RELEASE, "agent"); asm volatile("s_waitcnt vmcnt(0)" ::: "memory"); __hip_atomic_fetch_add(cnt + 64 * pm, 1u, __ATOMIC_RELAXED, __HIP_MEMORY_SCOPE_AGENT); }
        unsigned sp = 0;
        while ((unsigned)__builtin_amdgcn_readfirstlane(__hip_atomic_load(cnt + 64 * pm, __ATOMIC_RELAXED, __HIP_MEMORY_SCOPE_AGENT)) < 4u) { __builtin_amdgcn_s_sleep(2); if (++sp > (1u << 22)) break; }
        __builtin_amdgcn_fence(__ATOMIC_ACQUIRE, "agent");
        asm volatile("s_waitcnt vmcnt(0)" ::: "memory");
    }
    asm volatile("" ::: "memory"); __builtin_amdgcn_s_barrier(); asm volatile("" ::: "memory");
}
__device__ __forceinline__ float bfl(unsigned w) { return __uint_as_float(w << 16); }
__device__ __forceinline__ float bfh(unsigned w) { return __uint_as_float(w & 0xffff0000u); }
struct EpiResid {
    static constexpr bool PERM = true, AFTER_DRAIN = true;
    const float* xin32; bf16_t* xb; float* ssq_out; float scale; unsigned* psync;
    __device__ __forceinline__ void fused(f32x4 (&acc)[2][2][4][2], const Unit& u, int wr, int wc, int fr, int fq, PG8_LAS unsigned char* lds, int wid, int lane) const {
        PG8_LAS float* P = (PG8_LAS float*)lds;
        const int row0 = u.pm * BM + wr * 64 + fr, col0 = u.pn * BM + wc * 32 + 8 * fq;
#pragma unroll
        for (int ai = 0; ai < 2; ++ai)
#pragma unroll
            for (int m = 0; m < 4; ++m) { const int row = row0 + ai * HALF + m * 16; const size_t off = (size_t)row * 1024 + col0; float ss = 0.f;
#pragma unroll
                for (int bj = 0; bj < 2; ++bj) { const size_t o = off + bj * HALF; f32x4 x0, x1;
                    if (xin32) { x0 = *(const f32x4*)(xin32 + o); x1 = *(const f32x4*)(xin32 + o + 4); }
                    else { const u32x4 w = *(const u32x4*)(xb + o); x0 = (f32x4){bfl(w.x), bfh(w.x), bfl(w.y), bfh(w.y)}; x1 = (f32x4){bfl(w.z), bfh(w.z), bfl(w.w), bfh(w.w)}; }
                    const f32x4 v0 = x0 + acc[ai][bj][m][0] * scale, v1 = x1 + acc[ai][bj][m][1] * scale;
                    ss += ((v0[0] * v0[0] + v0[1] * v0[1]) + (v0[2] * v0[2] + v0[3] * v0[3])) + ((v1[0] * v1[0] + v1[1] * v1[1]) + (v1[2] * v1[2] + v1[3] * v1[3]));
                    u32x4 w; w.x = cvt_pk_bf16(v0[0], v0[1]); w.y = cvt_pk_bf16(v0[2], v0[3]); w.z = cvt_pk_bf16(v1[0], v1[1]); w.w = cvt_pk_bf16(v1[2], v1[3]); st_wt16(xb + o, w); }
                ss += __shfl_xor(ss, 16); ss += __shfl_xor(ss, 32);
                if (fq == 0) P[(ai * HALF + wr * 64 + m * 16 + fr) * 4 + wc] = ss; }
        asm volatile("s_waitcnt lgkmcnt(0)" ::: "memory"); __builtin_amdgcn_s_barrier(); asm volatile("" ::: "memory");
        const int t = wid * 64 + lane;
        if (t < 256) { const f32x4 p = *(const PG8_LAS f32x4*)(P + t * 4); unsafeAtomicAdd(ssq_out + u.pm * BM + t, (p[0] + p[1]) + (p[2] + p[3])); }
        asm volatile("s_waitcnt lgkmcnt(0)" ::: "memory"); __builtin_amdgcn_s_barrier(); asm volatile("" ::: "memory");
        if (psync) panel_sync(psync, u.pm, wid, lane);
    }
};
struct EpiFinal {
    static constexpr bool PERM = true, AFTER_DRAIN = true;
    const bf16_t* xb; float* out; float* ssq; unsigned* cnt; const float* gain; float scale;
    __device__ __forceinline__ void fused(f32x4 (&acc)[2][2][4][2], const Unit& u, int wr, int wc, int fr, int fq, PG8_LAS unsigned char* lds, int wid, int lane) const {
        PG8_LAS float* P = (PG8_LAS float*)lds;
        const int row0 = u.pm * BM + wr * 64 + fr, col0 = u.pn * BM + wc * 32 + 8 * fq;
#pragma unroll
        for (int ai = 0; ai < 2; ++ai)
#pragma unroll
            for (int m = 0; m < 4; ++m) { const int row = row0 + ai * HALF + m * 16; const size_t off = (size_t)row * 1024 + col0; float ss = 0.f;
#pragma unroll
                for (int bj = 0; bj < 2; ++bj) { const u32x4 w = *(const u32x4*)(xb + off + bj * HALF);
                    const f32x4 x0 = {bfl(w.x), bfh(w.x), bfl(w.y), bfh(w.y)}, x1 = {bfl(w.z), bfh(w.z), bfl(w.w), bfh(w.w)};
                    const f32x4 v0 = x0 + acc[ai][bj][m][0] * scale, v1 = x1 + acc[ai][bj][m][1] * scale; acc[ai][bj][m][0] = v0; acc[ai][bj][m][1] = v1;
                    ss += ((v0[0] * v0[0] + v0[1] * v0[1]) + (v0[2] * v0[2] + v0[3] * v0[3])) + ((v1[0] * v1[0] + v1[1] * v1[1]) + (v1[2] * v1[2] + v1[3] * v1[3])); }
                ss += __shfl_xor(ss, 16); ss += __shfl_xor(ss, 32);
                if (fq == 0) P[(ai * HALF + wr * 64 + m * 16 + fr) * 4 + wc] = ss; }
        asm volatile("s_waitcnt lgkmcnt(0)" ::: "memory"); __builtin_amdgcn_s_barrier(); asm volatile("" ::: "memory");
        const int t = wid * 64 + lane;
        if (t < 256) { const f32x4 p = *(const PG8_LAS f32x4*)(P + t * 4); unsafeAtomicAdd(ssq + u.pm * BM + t, (p[0] + p[1]) + (p[2] + p[3])); }
        asm volatile("s_waitcnt vmcnt(0) lgkmcnt(0)" ::: "memory"); __builtin_amdgcn_s_barrier(); asm volatile("" ::: "memory");
        if (wid == 0) {
            if (lane == 0) __hip_atomic_fetch_add(cnt + 64 * u.pm, 1u, __ATOMIC_RELAXED, __HIP_MEMORY_SCOPE_AGENT);
            unsigned sp = 0;
            while ((unsigned)__builtin_amdgcn_readfirstlane(__hip_atomic_load(cnt + 64 * u.pm, __ATOMIC_RELAXED, __HIP_MEMORY_SCOPE_AGENT)) < 4u) { __builtin_amdgcn_s_sleep(2); if (++sp > (1u << 22)) break; }
        }
        asm volatile("s_waitcnt vmcnt(0) lgkmcnt(0)" ::: "memory"); __builtin_amdgcn_s_barrier(); asm volatile("" ::: "memory");
#pragma unroll
        for (int ai = 0; ai < 2; ++ai)
#pragma unroll
            for (int m = 0; m < 4; ++m) { const int row = row0 + ai * HALF + m * 16; const size_t off = (size_t)row * 1024 + col0;
                const float rs = rsqrtf(__hip_atomic_load(ssq + row, __ATOMIC_RELAXED, __HIP_MEMORY_SCOPE_AGENT) * (1.f / 1024.f) + RMS_EPS);
#pragma unroll
                for (int bj = 0; bj < 2; ++bj)
#pragma unroll
                    for (int n = 0; n < 2; ++n) { const f32x4 g = *(const f32x4*)(gain + col0 + bj * HALF + n * 4); *(f32x4*)(out + off + bj * HALF + n * 4) = acc[ai][bj][m][n] * rs * g; } }
    }
};
struct EpiWin {
    static constexpr bool PERM = true, AFTER_DRAIN = false;
    bf16_t *QS, *VV, *GS, *BC, *CU; _Float16* LF; const float* ssq; const float* lbl; int pn0;
    __device__ __forceinline__ void operator()(const f32x4 (&acc)[2][2][4][2], const Unit& u, int wr, int wc, int fr, int fq) const {
        const int row0 = u.pm * BM + wr * 64 + fr; const int pn = u.pn + pn0; const int cw = wc * 32 + 8 * fq;
        if (pn >= 10) {
#pragma unroll
            for (int ai = 0; ai < 2; ++ai)
#pragma unroll
                for (int m = 0; m < 4; ++m) { const int row = row0 + ai * HALF + m * 16; const float rs = row_rs(ssq, row); const float rs2 = rs * rs;
                    const f32x4 v0 = acc[ai][0][m][0] * acc[ai][1][m][0] * rs2, v1 = acc[ai][0][m][1] * acc[ai][1][m][1] * rs2; u32x4 w;
                    w.x = cvt_pk_bf16(v0[0], v0[1]); w.y = cvt_pk_bf16(v0[2], v0[3]); w.z = cvt_pk_bf16(v1[0], v1[1]); w.w = cvt_pk_bf16(v1[2], v1[3]);
                    *(u32x4*)(CU + (size_t)row * 512 + (pn - 10) * HALF + cw) = w; }
            return;
        }
        const int grp = pn >> 1;
        const int cbase = (pn & 1) * BM + cw;
        if (grp == 1) {
            float lb[2][2][4];
#pragma unroll
            for (int bj = 0; bj < 2; ++bj)
#pragma unroll
                for (int n = 0; n < 2; ++n) { const int c = cbase + bj * HALF + n * 4; const f32x4 l0 = *(const f32x4*)(lbl + c), l1 = *(const f32x4*)(lbl + 512 + c);
#pragma unroll
                    for (int j = 0; j < 4; ++j) lb[bj][n][j] = fsigm(l0[j] - l1[j]); }
#pragma unroll
            for (int ai = 0; ai < 2; ++ai)
#pragma unroll
                for (int m = 0; m < 4; ++m) { const int row = row0 + ai * HALF + m * 16; const float rs = row_rs(ssq, row);
#pragma unroll
                    for (int bj = 0; bj < 2; ++bj) { f16x4 o[2];
#pragma unroll
                        for (int n = 0; n < 2; ++n) { const f32x4 p = acc[ai][bj][m][n] * rs;
#pragma unroll
                            for (int j = 0; j < 4; ++j) { const float l = lb[bj][n][j]; const float f = l + (1.f - l) * fsigm(p[j]); o[n][j] = (_Float16)__logf(f); } }
                        const u32x2 a0 = __builtin_bit_cast(u32x2, o[0]), a1 = __builtin_bit_cast(u32x2, o[1]); u32x4 w; w.x = a0.x; w.y = a0.y; w.z = a1.x; w.w = a1.y;
                        *(u32x4*)(LF + (size_t)row * 512 + cbase + bj * HALF) = w; } }
            return;
        }
        bf16_t* dst = grp == 0 ? QS : (grp == 2 ? VV : (grp == 3 ? GS : BC)); const bool act = (grp == 0) || (grp == 3);
#pragma unroll
        for (int ai = 0; ai < 2; ++ai)
#pragma unroll
            for (int m = 0; m < 4; ++m) { const int row = row0 + ai * HALF + m * 16; const float rs = row_rs(ssq, row);
#pragma unroll
                for (int bj = 0; bj < 2; ++bj) { f32x4 p0 = acc[ai][bj][m][0] * rs, p1 = acc[ai][bj][m][1] * rs;
                    if (act) { p0[0] = fsilu(p0[0]); p0[1] = fsilu(p0[1]); p0[2] = fsilu(p0[2]); p0[3] = fsilu(p0[3]); p1[0] = fsilu(p1[0]); p1[1] = fsilu(p1[1]); p1[2] = fsilu(p1[2]); p1[3] = fsilu(p1[3]); }
                    u32x4 w; w.x = cvt_pk_bf16(p0[0], p0[1]); w.y = cvt_pk_bf16(p0[2], p0[3]); w.z = cvt_pk_bf16(p1[0], p1[1]); w.w = cvt_pk_bf16(p1[2], p1[3]);
                    *(u32x4*)(dst + (size_t)row * 512 + cbase + bj * HALF) = w; } }
    }
};
}
#define LAS __attribute__((address_space(3)))
typedef unsigned short bf16;
typedef unsigned v4u __attribute__((ext_vector_type(4)));
typedef unsigned v2u __attribute__((ext_vector_type(2)));
typedef float f32x4 __attribute__((ext_vector_type(4)));
typedef float f32x16 __attribute__((ext_vector_type(16)));
typedef short bf16x8 __attribute__((ext_vector_type(8)));
typedef short s16x4 __attribute__((ext_vector_type(4)));
constexpr int NWAVES = 8, NT = NWAVES * 64;
constexpr int M = 16384, D = 1024, FF = 2816, IC = 3584, SEQ = 4096, NB = 4, NMEM = 256;
constexpr float EPS = 1e-6f;
constexpr size_t MiB = 1u << 20;
constexpr size_t WS_SSQ = 0;
constexpr size_t WS_DEC = 512 * 1024;
constexpr size_t WS_WGU1 = 1 * MiB, WS_WD1 = 12 * MiB, WS_WIN = 18 * MiB, WS_WOUT = 25 * MiB, WS_WQ = 27 * MiB, WS_WKV = 29 * MiB, WS_WO = 33 * MiB, WS_WGU2 = 35 * MiB, WS_WD2 = 46 * MiB;
constexpr size_t WS_XB = 54 * MiB;
constexpr size_t WS_KB = 86 * MiB, WS_VT = 88 * MiB, WS_MEMN = 90 * MiB;
constexpr size_t WS_R = 96 * MiB;
constexpr size_t WS_H = WS_R;
constexpr size_t WS_QS = WS_R, WS_LF = WS_R + 16 * MiB, WS_VV = WS_R + 32 * MiB, WS_GS = WS_R + 48 * MiB, WS_BC = WS_R + 64 * MiB, WS_CU = WS_R + 80 * MiB;
constexpr size_t WS_ST = WS_R + 96 * MiB, WS_MIX = WS_R + 128 * MiB;
constexpr size_t WS_O = WS_ST;
constexpr size_t WS_END = 256 * MiB;
static_assert(WS_WD2 + (size_t)D * FF * 2 <= WS_XB && WS_MIX + (size_t)M * D * 2 <= WS_END && WS_H + (size_t)M * FF * 2 <= WS_END, "ws map");
constexpr int LDS_BYTES = 147456;
constexpr int MISC_OFF = LDS_BYTES - 64;
constexpr size_t WS_BAR = 400 * 1024, WS_CNT = WS_BAR + 16384, BAR_BYTES = 65536 + 4096;

__device__ __forceinline__ unsigned pk2(float lo, float hi) { return pg8::cvt_pk_bf16(lo, hi); }
__device__ __forceinline__ float bf2f(unsigned short u) { return __uint_as_float((unsigned)u << 16); }
__device__ __forceinline__ float wave_sum(float v) {
#pragma unroll
    for (int o = 1; o < 64; o <<= 1) v += __shfl_xor(v, o);
    return v;
}
#define LDS_WAIT() asm volatile("s_waitcnt lgkmcnt(0)" ::: "memory")
#define LBAR() do { asm volatile("s_waitcnt lgkmcnt(0)" ::: "memory"); __builtin_amdgcn_s_barrier(); asm volatile("" ::: "memory"); } while (0)

__device__ __forceinline__ int rowmap(int mode, int n0, int N) {
    if (mode == 1) { const int half = N / 2, isup = n0 >= half ? 1 : 0, j = n0 - isup * half; return (j / 128) * 256 + isup * 128 + (j % 128); }
    if (mode == 2) { if (n0 < 2560) return n0; int j = n0 - 2560; const int isu = j >= 512 ? 1 : 0; j -= isu * 512; return 2560 + (j / 128) * 256 + isu * 128 + (j % 128); }
    return n0;
}
struct P0Desc { const float* W; bf16* WT; const float* gain; float scale; int K, N, mode, item; };
__device__ __forceinline__ void p0_load(const P0Desc& d, float (&v)[32], int lane) {
    const int nblk = d.N / 32, kb = d.item / nblk, nb = d.item % nblk, k0 = 64 * kb, n0 = 32 * nb;
    const float* p = d.W + (size_t)(k0 + (lane >> 5)) * d.N + n0 + (lane & 31);
#pragma unroll
    for (int i = 0; i < 32; ++i) v[i] = __builtin_nontemporal_load(p + (size_t)(2 * i) * d.N);
}
__device__ __forceinline__ void p0_store(const P0Desc& d, const float (&v)[32], LAS float* scr, int lane) {
    const int nblk = d.N / 32, kb = d.item / nblk, nb = d.item % nblk, k0 = 64 * kb, n0 = 32 * nb;
#pragma unroll
    for (int i = 0; i < 32; ++i) scr[(2 * i + (lane >> 5)) * 33 + (lane & 31)] = v[i];
    LDS_WAIT(); asm volatile("" ::: "memory");
    const int c = lane & 7; const int r0 = rowmap(d.mode, n0, d.N);
    f32x4 g0 = {d.scale, d.scale, d.scale, d.scale}, g1 = g0;
    if (d.gain) { g0 = *(const f32x4*)(d.gain + k0 + 8 * c) * d.scale; g1 = *(const f32x4*)(d.gain + k0 + 8 * c + 4) * d.scale; }
#pragma unroll
    for (int j = 0; j < 4; ++j) { const int n = (lane >> 3) + 8 * j; const LAS float* q = scr + (8 * c) * 33 + n;
        v4u o; o.x = pk2(q[0 * 33] * g0[0], q[1 * 33] * g0[1]); o.y = pk2(q[2 * 33] * g0[2], q[3 * 33] * g0[3]); o.z = pk2(q[4 * 33] * g1[0], q[5 * 33] * g1[1]); o.w = pk2(q[6 * 33] * g1[2], q[7 * 33] * g1[3]);
        pg8::st_wt16(d.WT + (size_t)(r0 + n) * d.K + k0 + 8 * c, o); }
    LDS_WAIT(); asm volatile("" ::: "memory");
}

struct Args { const float* in[21]; float* out; unsigned char* ws; int ph_lo, ph_hi; };
enum { I_X = 0, I_MEM, I_F1N, I_F1GU, I_F1D, I_MIXN, I_WIN, I_LB, I_HGN, I_CONVW, I_CONVN, I_WOUT, I_XAN, I_MEMNORM, I_WQ, I_WKV, I_WO, I_F2N, I_F2GU, I_F2D, I_FINN };

struct P0Tab { int in_w, in_g, K, N, mode, first; float scale; unsigned pad; unsigned long long wt_off; };
constexpr int PI_GU = (D / 64) * (2 * FF / 32), PI_DN = (FF / 64) * (D / 32), PI_IN = (D / 64) * (IC / 32), PI_SQ = (D / 64) * (D / 32), PI_KV = (D / 64) * (2 * D / 32);
__device__ const P0Tab P0TAB[9] = {
    {I_F1GU, I_F1N, D, 2 * FF, 1, 0, 1.f, 0u, WS_WGU1},
    {I_WKV, -1, D, 2 * D, 0, PI_GU, 1.f, 0u, WS_WKV},
    {I_F1D, -1, FF, D, 0, PI_GU + PI_KV, 1.f, 0u, WS_WD1},
    {I_WIN, I_MIXN, D, IC, 2, PI_GU + PI_KV + PI_DN, 1.f, 0u, WS_WIN},
    {I_WOUT, -1, D, D, 0, PI_GU + PI_KV + PI_DN + PI_IN, 1.f, 0u, WS_WOUT},
    {I_WQ, I_XAN, D, D, 0, PI_GU + PI_KV + PI_DN + PI_IN + PI_SQ, 0.0625f, 0u, WS_WQ},
    {I_WO, -1, D, D, 0, PI_GU + PI_KV + PI_DN + PI_IN + 2 * PI_SQ, 1.f, 0u, WS_WO},
    {I_F2GU, I_F2N, D, 2 * FF, 1, PI_GU + PI_KV + PI_DN + PI_IN + 3 * PI_SQ, 1.f, 0u, WS_WGU2},
    {I_F2D, -1, FF, D, 0, 2 * PI_GU + PI_KV + PI_DN + PI_IN + 3 * PI_SQ, 1.f, 0u, WS_WD2},
};
constexpr int P0_EARLY = PI_GU + PI_KV, P0_MID = PI_GU + PI_KV + PI_DN + PI_IN + 3 * PI_SQ, P0_GU2 = P0_MID + PI_GU, P0_ALL = P0_GU2 + PI_DN;

__device__ __forceinline__ void p0_items(const Args& a, LAS float* scr, int first, int last, int w, int nw, int lane) {
    unsigned char* ws = a.ws;
    auto desc = [&](int it) -> P0Desc {
        int mi = 0;
#pragma unroll
        for (int j = 1; j < 9; ++j) mi += (it >= P0TAB[j].first) ? 1 : 0;
        const P0Tab t = P0TAB[mi];
        P0Desc d; d.W = a.in[t.in_w]; d.WT = (bf16*)(ws + t.wt_off); d.gain = t.in_g >= 0 ? a.in[t.in_g] : nullptr; d.scale = t.scale; d.K = t.K; d.N = t.N; d.mode = t.mode; d.item = it - t.first;
        return d;
    };
    float va[32], vb[32]; int it = first + w;
    P0Desc da = desc(it < last ? it : first), db = da;
    if (it < last) p0_load(da, va, lane);
    while (it < last) {
        const int n1 = it + nw; if (n1 < last) { db = desc(n1); p0_load(db, vb, lane); }
        p0_store(da, va, scr, lane);
        if (n1 >= last) break;
        const int n2 = n1 + nw; if (n2 < last) { da = desc(n2); p0_load(da, va, lane); }
        p0_store(db, vb, scr, lane);
        it = n2;
    }
}
__device__ __forceinline__ void p0_prologue(const Args& a, LAS unsigned char* lds, int gw, int NGW, int wave, int lane) {
    unsigned char* ws = a.ws;
    LAS float* scr = (LAS float*)(lds + wave * 16384);
    p0_items(a, scr, 0, P0_EARLY, gw, NGW, lane);
    float* ssq = (float*)(ws + WS_SSQ);
    for (int m = gw; m < M; m += 2 * NGW) {
        const int m1 = m + NGW;
        const f32x4* xr0 = (const f32x4*)(a.in[I_X] + (size_t)m * D) + lane; const f32x4* xr1 = (const f32x4*)(a.in[I_X] + (size_t)(m1 < M ? m1 : m) * D) + lane; f32x4 v[4], w4[4]; float s = 0.f, s1 = 0.f;
#pragma unroll
        for (int j = 0; j < 4; ++j) { v[j] = __builtin_nontemporal_load(xr0 + 64 * j); w4[j] = __builtin_nontemporal_load(xr1 + 64 * j); }
#pragma unroll
        for (int j = 0; j < 4; ++j) { s += (v[j][0] * v[j][0] + v[j][1] * v[j][1]) + (v[j][2] * v[j][2] + v[j][3] * v[j][3]); s1 += (w4[j][0] * w4[j][0] + w4[j][1] * w4[j][1]) + (w4[j][2] * w4[j][2] + w4[j][3] * w4[j][3]); }
        s = wave_sum(s); s1 = wave_sum(s1); if (lane == 0) { ssq[m] = s; if (m1 < M) ssq[m1] = s1; }
        v2u* o = (v2u*)((bf16*)(ws + WS_XB) + (size_t)m * D) + lane;
#pragma unroll
        for (int j = 0; j < 4; ++j) { v2u w; w.x = pk2(v[j][0], v[j][1]); w.y = pk2(v[j][2], v[j][3]); o[64 * j] = w; }
        if (m1 < M) { v2u* o1 = (v2u*)((bf16*)(ws + WS_XB) + (size_t)m1 * D) + lane;
#pragma unroll
            for (int j = 0; j < 4; ++j) { v2u w; w.x = pk2(w4[j][0], w4[j][1]); w.y = pk2(w4[j][2], w4[j][3]); o1[64 * j] = w; } }
    }
    for (int m = gw; m < NB * NMEM; m += NGW) {
        const f32x4* xr = (const f32x4*)(a.in[I_MEM] + (size_t)m * D) + lane; const f32x4* gr = (const f32x4*)(a.in[I_MEMNORM]) + lane; f32x4 v[4]; float s = 0.f;
#pragma unroll
        for (int j = 0; j < 4; ++j) { v[j] = xr[64 * j]; s += (v[j][0] * v[j][0] + v[j][1] * v[j][1]) + (v[j][2] * v[j][2] + v[j][3] * v[j][3]); }
        s = wave_sum(s); const float rs = rsqrtf(s * (1.f / D) + EPS);
        v2u* o = (v2u*)((bf16*)(ws + WS_MEMN) + (size_t)m * D) + lane;
#pragma unroll
        for (int j = 0; j < 4; ++j) { const f32x4 g = gr[64 * j]; v2u w; w.x = pk2(v[j][0] * rs * g[0], v[j][1] * rs * g[1]); w.y = pk2(v[j][2] * rs * g[2], v[j][3] * rs * g[3]); o[64 * j] = w; }
    }
    for (int i = gw * 64 + lane; i < 4 * M; i += NGW * 64) ssq[M + i] = 0.f;
}

constexpr int GP = 264;
__device__ __forceinline__ void hg_a2_quad(unsigned char* ws, float* Gp, LAS unsigned char* lds, int quad, int tid) {
    const int k = tid & 127, seg = tid >> 7, lane = tid & 63, wave = tid >> 6, l15 = lane & 15, lq = lane >> 4;
    LAS float* segsum = (LAS float*)lds;
    LAS float* dl = (LAS float*)(lds + 2048);
    LAS bf16* KPt = (LAS bf16*)(lds + 2560);
    LAS bf16* Vt = KPt + 128 * GP;
    f32x4 R[8];
#pragma unroll
    for (int kt = 0; kt < 8; ++kt) R[kt] = (f32x4){0.f, 0.f, 0.f, 0.f};
#pragma unroll 1
    for (int gi = 0; gi < 4; ++gi) {
        const int unit = quad * 4 + gi, bh = unit >> 4, g = unit & 15, b = bh >> 2, h = bh & 3, row0 = b * SEQ + g * 256;
        const size_t gofs = (size_t)(row0 + seg * 64) * 512 + h * 128 + k;
        const _Float16* lfp = (const _Float16*)(ws + WS_LF) + gofs; const bf16* vp = (const bf16*)(ws + WS_VV) + gofs;
        float lf[64]; unsigned vq[32];
#pragma unroll
        for (int i = 0; i < 64; ++i) lf[i] = (float)lfp[(size_t)i * 512];
#pragma unroll
        for (int i = 0; i < 32; ++i) vq[i] = (unsigned)vp[(size_t)(2 * i) * 512] | ((unsigned)vp[(size_t)(2 * i + 1) * 512] << 16);
        if (gi > 0) { float* pp = Gp + (size_t)unit * 16384 + (size_t)(wave * 8) * 256 + lane * 4;
#pragma unroll
            for (int kt = 0; kt < 8; ++kt) *(f32x4*)(pp + kt * 256) = R[kt]; }
        float run = 0.f;
#pragma unroll
        for (int i = 0; i < 64; ++i) run += lf[i];
        segsum[seg * 128 + k] = run;
#pragma unroll
        for (int i = 0; i < 8; ++i) *(LAS v4u*)(Vt + k * GP + seg * 64 + 8 * i) = (v4u){vq[4 * i], vq[4 * i + 1], vq[4 * i + 2], vq[4 * i + 3]};
        LBAR();
        const float s0 = segsum[k], s1 = segsum[128 + k], s2 = segsum[256 + k], s3 = segsum[384 + k];
        const float pre = (seg > 0 ? s0 : 0.f) + (seg > 1 ? s1 : 0.f) + (seg > 2 ? s2 : 0.f);
        const float blast = (s0 + s1) + (s2 + s3);
        run = pre;
#pragma unroll
        for (int i8 = 0; i8 < 8; ++i8) { unsigned kp[4];
#pragma unroll
            for (int j = 0; j < 4; ++j) { const float l0 = lf[8 * i8 + 2 * j], l1 = lf[8 * i8 + 2 * j + 1]; run += l0; const float a0 = (1.f - __expf(l0)) * __expf(blast - run); run += l1; const float a1 = (1.f - __expf(l1)) * __expf(blast - run); kp[j] = pk2(a0, a1); }
            *(LAS v4u*)(KPt + k * GP + seg * 64 + 8 * i8) = (v4u){kp[0], kp[1], kp[2], kp[3]}; }
        if (seg == 0) { const float e = __expf(blast); ((float*)(ws + WS_DEC))[unit * 128 + k] = e; dl[k] = e; }
        LBAR();
#pragma unroll
        for (int kt = 0; kt < 8; ++kt) { const f32x4 d = *(const LAS f32x4*)(dl + 16 * kt + 4 * lq); R[kt] = R[kt] * d; }
#pragma unroll
        for (int ss = 0; ss < 8; ++ss) { const bf16x8 y = *(const LAS bf16x8*)(Vt + (16 * wave + l15) * GP + 32 * ss + 8 * lq);
#pragma unroll
            for (int kt = 0; kt < 8; ++kt) { const bf16x8 x = *(const LAS bf16x8*)(KPt + (16 * kt + l15) * GP + 32 * ss + 8 * lq); R[kt] = __builtin_amdgcn_mfma_f32_16x16x32_bf16(x, y, R[kt], 0, 0, 0); } }
        LBAR();
    }
    float* tp = Gp + (size_t)(256 + quad) * 16384 + (size_t)(wave * 8) * 256 + lane * 4;
#pragma unroll
    for (int kt = 0; kt < 8; ++kt) *(f32x4*)(tp + kt * 256) = R[kt];
}
template <int NR>
__device__ __forceinline__ void conv_rows(const Args& a, int r0, int rstride, int lane) {
    unsigned char* ws = a.ws; const int c0 = 8 * lane;
    const bf16* BCp = (const bf16*)(ws + WS_BC); const bf16* CUp = (const bf16*)(ws + WS_CU);
    v4u bq[NR], u0[NR], u1[NR], u2[NR];
#pragma unroll
    for (int i = 0; i < NR; ++i) { const int row = r0 + i * rstride, t = row & (SEQ - 1);
        bq[i] = *(const v4u*)(BCp + (size_t)row * 512 + c0); u0[i] = *(const v4u*)(CUp + (size_t)row * 512 + c0);
        u1[i] = (v4u){0, 0, 0, 0}; u2[i] = (v4u){0, 0, 0, 0};
        if (t >= 1) u1[i] = *(const v4u*)(CUp + (size_t)(row - 1) * 512 + c0);
        if (t >= 2) u2[i] = *(const v4u*)(CUp + (size_t)(row - 2) * 512 + c0); }
    const float* cw = a.in[I_CONVW] + c0; const float* gn = a.in[I_CONVN] + c0;
    const f32x4 w0a = *(const f32x4*)(cw), w0b = *(const f32x4*)(cw + 4), w1a = *(const f32x4*)(cw + 512), w1b = *(const f32x4*)(cw + 516), w2a = *(const f32x4*)(cw + 1024), w2b = *(const f32x4*)(cw + 1028);
    const f32x4 ga = *(const f32x4*)(gn), gb = *(const f32x4*)(gn + 4);
#pragma unroll
    for (int i = 0; i < NR; ++i) { const int row = r0 + i * rstride; float y[8]; float s = 0.f;
#pragma unroll
        for (int j = 0; j < 8; ++j) { const int sh = (j & 1) * 16; const unsigned ub = bq[i][j >> 1], x0 = u0[i][j >> 1], x1 = u1[i][j >> 1], x2 = u2[i][j >> 1];
            const float B = __uint_as_float(((ub >> sh) & 0xffffu) << 16), c_0 = __uint_as_float(((x0 >> sh) & 0xffffu) << 16), c_1 = __uint_as_float(((x1 >> sh) & 0xffffu) << 16), c_2 = __uint_as_float(((x2 >> sh) & 0xffffu) << 16);
            const float k0 = j < 4 ? w0a[j & 3] : w0b[j & 3], k1 = j < 4 ? w1a[j & 3] : w1b[j & 3], k2 = j < 4 ? w2a[j & 3] : w2b[j & 3];
            y[j] = B * (k0 * c_2 + k1 * c_1 + k2 * c_0); s += y[j] * y[j]; }
        s = wave_sum(s); const float rs = rsqrtf(s * (1.f / 512.f) + EPS);
        v4u o; o.x = pk2(y[0] * rs * ga[0], y[1] * rs * ga[1]); o.y = pk2(y[2] * rs * ga[2], y[3] * rs * ga[3]); o.z = pk2(y[4] * rs * gb[0], y[5] * rs * gb[1]); o.w = pk2(y[6] * rs * gb[2], y[7] * rs * gb[3]);
        pg8::st_wt16((bf16*)(ws + WS_MIX) + (size_t)row * 1024 + 512 + c0, o); }
}
__device__ __forceinline__ void hg_c2_unit(const Args& a, const float* Gp, LAS unsigned char* lds, int unit, int tid) {
    unsigned char* ws = a.ws;
    const int bh = unit >> 4, g = unit & 15, b = bh >> 2, h = bh & 3;
    const int k = tid & 127, seg = tid >> 7, lane = tid & 63, wave = tid >> 6, l15 = lane & 15, lq = lane >> 4;
    LAS float* dl = (LAS float*)lds;
    LAS float* segsum = (LAS float*)(lds + 512);
    LAS float* part = (LAS float*)(lds + 2560);
    LAS bf16* QT = (LAS bf16*)(lds + 4096);
    LAS bf16* Q2 = QT + 64 * 136;
    LAS bf16* KT = Q2 + 64 * 136;
    LAS bf16* Vt = KT + 64 * 136;
    LAS bf16* AT = Vt + 128 * 72;
    LAS bf16* KPt = AT + 64 * 72;
    LAS bf16* SL = KPt + 128 * 72;
    f32x4 S[8];
#pragma unroll
    for (int kt = 0; kt < 8; ++kt) S[kt] = (f32x4){0.f, 0.f, 0.f, 0.f};
    {
        LAS float* DGL = (LAS float*)(SL + 128 * 136);
        for (int i = tid; i < 16 * 128; i += NT) DGL[i] = ((const float*)(ws + WS_DEC))[bh * 16 * 128 + i];
        const int q = g >> 2, gi = g & 3;
        const float* tbase = Gp + (size_t)(256 + bh * 4) * 16384 + (size_t)(wave * 8) * 256 + lane * 4;
        f32x4 ta[8], tb[8], tc[8], pg[8];
#pragma unroll
        for (int kt = 0; kt < 8; ++kt) { const f32x4 z = {0.f, 0.f, 0.f, 0.f};
            ta[kt] = q >= 1 ? *(const f32x4*)(tbase + (size_t)(q - 1) * 16384 + kt * 256) : z;
            tb[kt] = q >= 2 ? *(const f32x4*)(tbase + (size_t)(q - 2) * 16384 + kt * 256) : z;
            tc[kt] = q >= 3 ? *(const f32x4*)(tbase + (size_t)(q - 3) * 16384 + kt * 256) : z;
            pg[kt] = gi >= 1 ? *(const f32x4*)(Gp + (size_t)unit * 16384 + (size_t)(wave * 8) * 256 + lane * 4 + kt * 256) : z; }
        LBAR();
#pragma unroll
        for (int kt = 0; kt < 8; ++kt) { const int ko = 16 * kt + 4 * lq;
            auto dgv = [&](int gg) -> f32x4 { return *(const LAS f32x4*)(DGL + gg * 128 + ko); };
            f32x4 sq = ta[kt];
            if (q >= 2) { const f32x4 w1 = dgv(4 * (q - 1)) * dgv(4 * (q - 1) + 1) * dgv(4 * (q - 1) + 2) * dgv(4 * (q - 1) + 3); sq = sq + w1 * tb[kt];
                if (q >= 3) { const f32x4 w2 = w1 * (dgv(4 * (q - 2)) * dgv(4 * (q - 2) + 1) * dgv(4 * (q - 2) + 2) * dgv(4 * (q - 2) + 3)); sq = sq + w2 * tc[kt]; } }
            f32x4 e = {1.f, 1.f, 1.f, 1.f};
            if (gi >= 1) e = e * dgv(4 * q); if (gi >= 2) e = e * dgv(4 * q + 1); if (gi >= 3) e = e * dgv(4 * q + 2);
            S[kt] = e * sq + pg[kt]; }
    }
    _Float16 nlf[16]; bf16 nvv[16], nqq[16];
    {   const size_t gofs = (size_t)(b * SEQ + g * 256 + seg * 16) * 512 + h * 128 + k;
        const _Float16* lfp = (const _Float16*)(ws + WS_LF) + gofs; const bf16* vp = (const bf16*)(ws + WS_VV) + gofs; const bf16* qp = (const bf16*)(ws + WS_QS) + gofs;
#pragma unroll
        for (int i = 0; i < 16; ++i) { nlf[i] = lfp[(size_t)i * 512]; nvv[i] = vp[(size_t)i * 512]; nqq[i] = qp[(size_t)i * 512]; } }
#pragma unroll 1
    for (int cc = 0; cc < 4; ++cc) {
        const int row0 = b * SEQ + (g * 4 + cc) * 64;
        float lf[16], bc[16]; bf16 vv[16], qq[16];
#pragma unroll
        for (int i = 0; i < 16; ++i) { lf[i] = (float)nlf[i]; vv[i] = nvv[i]; qq[i] = nqq[i]; }
#pragma unroll
        for (int kt = 0; kt < 8; ++kt) { v2u w; w.x = pk2(S[kt][0], S[kt][1]); w.y = pk2(S[kt][2], S[kt][3]); *(LAS v2u*)(SL + (16 * wave + l15) * 136 + 16 * kt + 4 * lq) = w; }
        float run = 0.f;
#pragma unroll
        for (int i = 0; i < 16; ++i) { run += lf[i]; bc[i] = run; }
        segsum[seg * 128 + k] = run;
        {   unsigned vq[8];
#pragma unroll
            for (int i = 0; i < 8; ++i) vq[i] = (unsigned)vv[2 * i] | ((unsigned)vv[2 * i + 1] << 16);
            *(LAS v4u*)(Vt + k * 72 + seg * 16) = (v4u){vq[0], vq[1], vq[2], vq[3]}; *(LAS v4u*)(Vt + k * 72 + seg * 16 + 8) = (v4u){vq[4], vq[5], vq[6], vq[7]}; }
        LBAR();
        const float s0 = segsum[k], s1 = segsum[128 + k], s2 = segsum[256 + k], s3 = segsum[384 + k];
        const float pre = (seg > 0 ? s0 : 0.f) + (seg > 1 ? s1 : 0.f) + (seg > 2 ? s2 : 0.f);
        const float br = s0 + s1, blast = (s0 + s1) + (s2 + s3);
        unsigned kp[8];
        const float Ebr = __expf(br), Ebl = __expf(blast - br);
#pragma unroll
        for (int i = 0; i < 16; ++i) { const int s = seg * 16 + i; const float bb = pre + bc[i]; const float q = bf2f(qq[i]); const float kk = 1.f - __expf(lf[i]);
            const float e1 = __expf(fminf(fmaxf(bb - br, -80.f), 80.f)), e3 = __builtin_amdgcn_rcpf(e1), e2 = e1 * Ebr, e4 = e3 * Ebl;
            const unsigned w1 = pk2(q * e1, q * e2), w3 = pk2(kk * e3, kk * e4);
            QT[s * 136 + k] = (bf16)(w1 & 0xffffu); Q2[s * 136 + k] = (bf16)(w1 >> 16); KT[s * 136 + k] = (bf16)(w3 & 0xffffu);
            if (i & 1) kp[i >> 1] |= (w3 & 0xffff0000u); else kp[i >> 1] = w3 >> 16; }
        *(LAS v4u*)(KPt + k * 72 + seg * 16) = (v4u){kp[0], kp[1], kp[2], kp[3]}; *(LAS v4u*)(KPt + k * 72 + seg * 16 + 8) = (v4u){kp[4], kp[5], kp[6], kp[7]};
        if (seg == 0) dl[k] = __expf(blast);
        if (cc < 3) {
            const size_t gofs = (size_t)(row0 + 64 + seg * 16) * 512 + h * 128 + k;
            const _Float16* lfp = (const _Float16*)(ws + WS_LF) + gofs; const bf16* vp = (const bf16*)(ws + WS_VV) + gofs; const bf16* qp = (const bf16*)(ws + WS_QS) + gofs;
#pragma unroll
            for (int i = 0; i < 16; ++i) { nlf[i] = lfp[(size_t)i * 512]; nvv[i] = vp[(size_t)i * 512]; nqq[i] = qp[(size_t)i * 512]; } }
        v2u gsw4[4]; f32x4 gn4[4];
        {   const int tq = 16 * (wave & 3) + l15; const size_t orow_ = (size_t)(row0 + tq);
#pragma unroll
            for (int n = 0; n < 4; ++n) { const int v0 = 64 * (wave >> 2) + 16 * n + 4 * lq; gsw4[n] = *(const v2u*)((const bf16*)(ws + WS_GS) + orow_ * 512 + h * 128 + v0); gn4[n] = *(const f32x4*)(a.in[I_HGN] + v0); } }
        LBAR();
        {
            const int tt = wave >> 1;
#pragma unroll
            for (int si = 0; si < 2; ++si) { const int st = 2 * (wave & 1) + si; f32x4 acc = {0.f, 0.f, 0.f, 0.f};
                if (st <= tt) {
#pragma unroll
                    for (int kk = 0; kk < 4; ++kk) { const bf16x8 x = *(const LAS bf16x8*)(KT + (16 * st + l15) * 136 + 32 * kk + 8 * lq), y = *(const LAS bf16x8*)(QT + (16 * tt + l15) * 136 + 32 * kk + 8 * lq);
                        acc = __builtin_amdgcn_mfma_f32_16x16x32_bf16(x, y, acc, 0, 0, 0); } }
                const int t = 16 * tt + l15, sb = 16 * st + 4 * lq;
#pragma unroll
                for (int r = 0; r < 4; ++r) if (sb + r > t) acc[r] = 0.f;
                v2u w; w.x = pk2(acc[0], acc[1]); w.y = pk2(acc[2], acc[3]); *(LAS v2u*)(AT + t * 72 + sb) = w; }
        }
        LBAR();
        const int tt = wave & 3, vh = wave >> 2; f32x4 acc[4];
#pragma unroll
        for (int n = 0; n < 4; ++n) acc[n] = (f32x4){0.f, 0.f, 0.f, 0.f};
#pragma unroll
        for (int kk = 0; kk < 4; ++kk) { const bf16x8 y = *(const LAS bf16x8*)(Q2 + (16 * tt + l15) * 136 + 32 * kk + 8 * lq);
#pragma unroll
            for (int n = 0; n < 4; ++n) { const bf16x8 x = *(const LAS bf16x8*)(SL + (64 * vh + 16 * n + l15) * 136 + 32 * kk + 8 * lq); acc[n] = __builtin_amdgcn_mfma_f32_16x16x32_bf16(x, y, acc[n], 0, 0, 0); } }
#pragma unroll
        for (int ss = 0; ss < 2; ++ss) { const bf16x8 y = *(const LAS bf16x8*)(AT + (16 * tt + l15) * 72 + 32 * ss + 8 * lq);
#pragma unroll
            for (int n = 0; n < 4; ++n) { const bf16x8 x = *(const LAS bf16x8*)(Vt + (64 * vh + 16 * n + l15) * 72 + 32 * ss + 8 * lq); acc[n] = __builtin_amdgcn_mfma_f32_16x16x32_bf16(x, y, acc[n], 0, 0, 0); } }
        float ssq = 0.f;
#pragma unroll
        for (int n = 0; n < 4; ++n) ssq += (acc[n][0] * acc[n][0] + acc[n][1] * acc[n][1]) + (acc[n][2] * acc[n][2] + acc[n][3] * acc[n][3]);
        ssq += __shfl_xor(ssq, 16); ssq += __shfl_xor(ssq, 32);
        const int t = 16 * tt + l15;
        if (lq == 0) part[vh * 64 + t] = ssq;
#pragma unroll
        for (int kt = 0; kt < 8; ++kt) { const f32x4 d = *(const LAS f32x4*)(dl + 16 * kt + 4 * lq); S[kt] = S[kt] * d;
#pragma unroll
            for (int ss = 0; ss < 2; ++ss) { const bf16x8 x = *(const LAS bf16x8*)(KPt + (16 * kt + l15) * 72 + 32 * ss + 8 * lq), y = *(const LAS bf16x8*)(Vt + (16 * wave + l15) * 72 + 32 * ss + 8 * lq);
                S[kt] = __builtin_amdgcn_mfma_f32_16x16x32_bf16(x, y, S[kt], 0, 0, 0); } }
        LBAR();
        const float rs = rsqrtf((part[t] + part[64 + t]) * (1.f / 128.f) + EPS);
        const size_t orow = (size_t)(row0 + t);
#pragma unroll
        for (int n = 0; n < 4; ++n) { const int v0 = 64 * vh + 16 * n + 4 * lq; const v2u gsw = gsw4[n]; const f32x4 gn = gn4[n];
            const float o0 = acc[n][0] * rs * gn[0] * __uint_as_float(gsw.x << 16), o1 = acc[n][1] * rs * gn[1] * __uint_as_float(gsw.x & 0xffff0000u);
            const float o2 = acc[n][2] * rs * gn[2] * __uint_as_float(gsw.y << 16), o3 = acc[n][3] * rs * gn[3] * __uint_as_float(gsw.y & 0xffff0000u);
            v2u w; w.x = pk2(o0, o1); w.y = pk2(o2, o3); pg8::st_wt8((bf16*)(ws + WS_MIX) + orow * 1024 + h * 128 + v0, w); }
        LBAR();
    }
}
constexpr int XP = 264;
__device__ __forceinline__ void stage_half(const bf16* g, LAS bf16* dst, int tid) {
    v4u t[8];
#pragma unroll
    for (int i = 0; i < 8; ++i) { const int ch = tid + i * NT, r = ch >> 5, cc = ch & 31; t[i] = *(const v4u*)(g + (size_t)r * 1024 + cc * 8); }
#pragma unroll
    for (int i = 0; i < 8; ++i) { const int ch = tid + i * NT, r = ch >> 5, cc = ch & 31; *(LAS v4u*)(dst + r * XP + cc * 8) = t[i]; }
}
__device__ __forceinline__ void xattn_core(unsigned char* ws, LAS unsigned char* lds, int b, int hd, int qb, int tid, const bf16x8 (&qf)[16]) {
    const int lane = tid & 63, wave = tid >> 6, r32 = lane & 31, hh = lane >> 5;
    LAS bf16* L0 = (LAS bf16*)lds; LAS bf16* L1 = L0 + 128 * XP;
    const bf16* Kg = (const bf16*)(ws + WS_KB) + (size_t)(b * 256) * 1024 + hd * 256;
    const bf16* Vg = (const bf16*)(ws + WS_VT) + (size_t)(hd * 256) * 1024 + b * 256;
    stage_half(Kg, L0, tid); stage_half(Kg + (size_t)128 * 1024, L1, tid);
    const int q0 = b * SEQ + qb * 256 + 32 * wave;
    __syncthreads();
    f32x16 sacc[8];
#pragma unroll
    for (int mt = 0; mt < 8; ++mt) {
#pragma unroll
        for (int r = 0; r < 16; ++r) sacc[mt][r] = 0.f;
        const LAS bf16* kp = (mt < 4 ? L0 : L1) + ((mt & 3) * 32 + r32) * XP + 8 * hh;
#pragma unroll
        for (int ds = 0; ds < 16; ++ds) { const bf16x8 kf = *(const LAS bf16x8*)(kp + 16 * ds); sacc[mt] = __builtin_amdgcn_mfma_f32_32x32x16_bf16(kf, qf[ds], sacc[mt], 0, 0, 0); } }
    __syncthreads();
    stage_half(Vg, L0, tid); stage_half(Vg + (size_t)128 * 1024, L1, tid);
    float mx = -3.0e38f;
#pragma unroll
    for (int mt = 0; mt < 8; ++mt)
#pragma unroll
        for (int r = 0; r < 16; ++r) mx = fmaxf(mx, sacc[mt][r]);
    mx = fmaxf(mx, __shfl_xor(mx, 32));
    float sum = 0.f; bf16x8 pf[8][2];
#pragma unroll
    for (int mt = 0; mt < 8; ++mt) {
        float e[16];
#pragma unroll
        for (int r = 0; r < 16; ++r) { e[r] = __expf(sacc[mt][r] - mx); sum += e[r]; }
#pragma unroll
        for (int s = 0; s < 2; ++s) { v4u w; w.x = pk2(e[8 * s], e[8 * s + 1]); w.y = pk2(e[8 * s + 2], e[8 * s + 3]); w.z = pk2(e[8 * s + 4], e[8 * s + 5]); w.w = pk2(e[8 * s + 6], e[8 * s + 7]); pf[mt][s] = __builtin_bit_cast(bf16x8, w); }
    }
    sum += __shfl_xor(sum, 32);
    const float inv = 1.f / sum;
    __syncthreads();
    bf16* op = (bf16*)(ws + WS_O) + (size_t)(q0 + r32) * 1024 + hd * 256 + 4 * hh;
#pragma unroll 1
    for (int dt = 0; dt < 8; ++dt) {
        f32x16 o;
#pragma unroll
        for (int r = 0; r < 16; ++r) o[r] = 0.f;
        const LAS bf16* vpb = (dt < 4 ? L0 : L1) + ((dt & 3) * 32 + r32) * XP + 4 * hh;
#pragma unroll
        for (int mt = 0; mt < 8; ++mt)
#pragma unroll
            for (int s = 0; s < 2; ++s) { const v2u lo = *(const LAS v2u*)(vpb + 32 * mt + 16 * s), hi = *(const LAS v2u*)(vpb + 32 * mt + 16 * s + 8);
                const v4u vw = {lo.x, lo.y, hi.x, hi.y}; o = __builtin_amdgcn_mfma_f32_32x32x16_bf16(__builtin_bit_cast(bf16x8, vw), pf[mt][s], o, 0, 0, 0); }
#pragma unroll
        for (int g = 0; g < 4; ++g) { v2u w; w.x = pk2(o[4 * g] * inv, o[4 * g + 1] * inv); w.y = pk2(o[4 * g + 2] * inv, o[4 * g + 3] * inv); pg8::st_wt8(op + 32 * dt + 8 * g, w); }
    }
    __syncthreads();
}

struct EpiAttn {
    static constexpr bool PERM = false, AFTER_DRAIN = true;
    unsigned char* ws; const float* ssq; unsigned* psync;
    __device__ __forceinline__ void fused(f32x4 (&acc)[2][2][4][2], const pg8::Unit& u, int wr, int wc, int fr, int fq, LAS unsigned char* lds, int wid, int lane) const {
        LAS bf16* QI = (LAS bf16*)lds;
#pragma unroll
        for (int ai = 0; ai < 2; ++ai)
#pragma unroll
            for (int m = 0; m < 4; ++m) { const int rl = ai * 128 + wr * 64 + m * 16 + fr; const float rs = pg8::row_rs(ssq, u.pm * 256 + rl);
#pragma unroll
                for (int bj = 0; bj < 2; ++bj)
#pragma unroll
                    for (int n = 0; n < 2; ++n) { const f32x4 v = acc[ai][bj][m][n] * rs; v2u w; w.x = pk2(v[0], v[1]); w.y = pk2(v[2], v[3]);
                        *(LAS v2u*)(QI + rl * XP + bj * 128 + wc * 32 + n * 16 + 4 * fq) = w; } }
        __syncthreads();
        const int r32 = lane & 31, hh = lane >> 5; bf16x8 qf[16];
#pragma unroll
        for (int ds = 0; ds < 16; ++ds) qf[ds] = *(const LAS bf16x8*)(QI + (32 * wid + r32) * XP + 16 * ds + 8 * hh);
        __syncthreads();
        xattn_core(ws, lds, u.pm >> 4, u.pn, u.pm & 15, wid * 64 + lane, qf);
        if (psync) pg8::panel_sync(psync, u.pm, wid, lane);
    }
};

#define XB_TMO      128
#define XB_XCNT(j)  (256  + 64 * (j))
#define XB_XSUB(j)  (1280 + 64 * (j))
#define XB_XGEN(j)  (2304 + 64 * (j))
#define XB_TOP      3328
#define XB_TOPGEN   3392
#define XCD_BAR_WORDS 3456
#define XB_SPIN_CAP (1u << 18)

__device__ __forceinline__ unsigned xb_ld(unsigned* p)              { return __hip_atomic_load(p, __ATOMIC_RELAXED, __HIP_MEMORY_SCOPE_AGENT); }
__device__ __forceinline__ unsigned xb_add(unsigned* p, unsigned v) { return __hip_atomic_fetch_add(p, v, __ATOMIC_RELAXED, __HIP_MEMORY_SCOPE_AGENT); }
__device__ __forceinline__ unsigned xb_xcc_id() { return (unsigned)__builtin_amdgcn_s_getreg((3 << 11) | 20) & 0xFu; }
#define XB_SPIN(cond, bar) do { unsigned _sp = 0; while (cond) { __builtin_amdgcn_s_sleep(1); \
    if ((++_sp & 255u) == 0u) { if (xb_ld(&(bar)[XB_TMO])) break; if (_sp > XB_SPIN_CAP) { atomicAdd(&(bar)[XB_TMO], 1u); break; } } } } while (0)

struct XcdBarrier {
    unsigned* bar; unsigned x;
    volatile LAS unsigned* st;
};

__device__ __forceinline__ XcdBarrier xcd_barrier_post(unsigned* bar, volatile LAS unsigned* st) {
    XcdBarrier b; b.bar = bar; b.x = xb_xcc_id(); b.st = st;
    if (threadIdx.x == 0) (void)xb_add(&bar[XB_XCNT(b.x)], 1u);
    return b;
}
__device__ __forceinline__ void xcd_barrier_complete(unsigned* bar, unsigned x, unsigned& nloc, unsigned& nx) {
    const unsigned G = gridDim.x * gridDim.y * gridDim.z;
    unsigned sum, cnt, mine, sp = 0u;
    for (;;) {
        sum = 0u; cnt = 0u; mine = 0u;
#pragma unroll
        for (unsigned j = 0; j < 16; ++j) { const unsigned c = xb_ld(&bar[XB_XCNT(j)]); sum += c; cnt += (c > 0u) ? 1u : 0u; mine = (j == x) ? c : mine; }
        if (sum == G) break;
        __builtin_amdgcn_s_sleep(1);
        if ((++sp & 255u) == 0u) { if (xb_ld(&bar[XB_TMO])) break; if (sp > XB_SPIN_CAP) { atomicAdd(&bar[XB_TMO], 1u); break; } }
    }
    nloc = mine > 0u ? mine : 1u; nx = cnt > 0u ? cnt : 1u;
}

__device__ __forceinline__ void xcd_barrier(const XcdBarrier& b) {
    asm volatile("s_waitcnt vmcnt(0)" ::: "memory");
    __syncthreads();
    if (threadIdx.x == 0) {
        unsigned* bar = b.bar;
        __builtin_amdgcn_s_waitcnt(0);
        unsigned nloc = b.st[0], nx = b.st[1];
        if (nloc == 0u) { xcd_barrier_complete(bar, b.x, nloc, nx); b.st[0] = nloc; b.st[1] = nx; }
        const unsigned old = xb_add(&bar[XB_XSUB(b.x)], 1u);
        const unsigned gen = old / nloc;
        if (old + 1u == (gen + 1u) * nloc) {
            __builtin_amdgcn_fence(__ATOMIC_RELEASE, "agent");
            asm volatile("s_waitcnt vmcnt(0)" ::: "memory");
            const unsigned og = xb_add(&bar[XB_TOP], 1u);
            const unsigned tg = og / nx;
            if (og + 1u == (tg + 1u) * nx) xb_add(&bar[XB_TOPGEN], 1u);
            else XB_SPIN(xb_ld(&bar[XB_TOPGEN]) == tg, bar);
            __builtin_amdgcn_fence(__ATOMIC_ACQUIRE, "agent");
            xb_add(&bar[XB_XGEN(b.x)], 1u);
            asm volatile("s_waitcnt vmcnt(0)" ::: "memory");
        } else {
            XB_SPIN(xb_ld(&bar[XB_XGEN(b.x)]) == gen, bar);
            __builtin_amdgcn_fence(__ATOMIC_ACQUIRE, "agent");
            asm volatile("s_waitcnt vmcnt(0)" ::: "memory");
        }
    }
    __syncthreads();
}

#ifndef FLAT_BAR
#define FLAT_BAR 0
#endif
__device__ __forceinline__ void flat_barrier(unsigned* cnt, unsigned& gen, unsigned G) {
    asm volatile("s_waitcnt vmcnt(0)" ::: "memory");
    __syncthreads();
    if (threadIdx.x == 0) {
        __builtin_amdgcn_fence(__ATOMIC_RELEASE, "agent");
        asm volatile("s_waitcnt vmcnt(0)" ::: "memory");
        __hip_atomic_fetch_add(cnt + 64 * (blockIdx.x & 7u), 1u, __ATOMIC_RELAXED, __HIP_MEMORY_SCOPE_AGENT);
        const unsigned target = (gen + 1u) * G; unsigned sp = 0;
        for (;;) { unsigned sum = 0;
#pragma unroll
            for (int j = 0; j < 8; ++j) sum += __hip_atomic_load(cnt + 64 * j, __ATOMIC_RELAXED, __HIP_MEMORY_SCOPE_AGENT);
            if (sum >= target) break;
            __builtin_amdgcn_s_sleep(1);
            if (++sp > (1u << 20)) break; }
        __builtin_amdgcn_fence(__ATOMIC_ACQUIRE, "agent");
        asm volatile("s_waitcnt vmcnt(0)" ::: "memory");
    }
    ++gen;
    __syncthreads();
}

constexpr int N_PHASES = 14;
#ifndef DUPMASK
#define DUPMASK 0
#endif
#define NREP(k) (1 + ((DUPMASK >> (k)) & 1))
__global__ void __launch_bounds__(NT, 2) hymba_fwd(Args args) {
    extern __shared__ __attribute__((aligned(16))) unsigned char lds_raw[];
    LAS unsigned char* lds = (LAS unsigned char*)lds_raw;
    const int tid = threadIdx.x, lane = tid & 63, wave = __builtin_amdgcn_readfirstlane(tid >> 6);
    const int G = gridDim.x, bx = blockIdx.x;
    const int vcu = (G % 8 == 0) ? (bx % 8) * (G / 8) + bx / 8 : bx;
    const int gw = vcu * NWAVES + wave, NGW = G * NWAVES;
    unsigned char* ws = args.ws;
    float* ssq = (float*)(ws + WS_SSQ);
    const int lo = args.ph_lo, hi = args.ph_hi;
#define IN(k) (lo <= (k) && (k) < hi)
#if FLAT_BAR
    unsigned fgen = 0;
#define SEAM(k) do { if (IN(k) && IN((k) + 1)) flat_barrier((unsigned*)(ws + WS_BAR + 65536), fgen, (unsigned)G); } while (0)
#else
#define SEAM(k) do { if (IN(k) && IN((k) + 1)) xcd_barrier(xbar); } while (0)
#endif
    bf16* XB = (bf16*)(ws + WS_XB); bf16* Hb = (bf16*)(ws + WS_H);
    if (lo < 0) cg::this_grid().sync();
    volatile LAS unsigned* MISC = (volatile LAS unsigned*)(lds + MISC_OFF);
    if (tid < 16) MISC[tid] = 0u;
    __syncthreads();
    XcdBarrier xbar = xcd_barrier_post((unsigned*)(ws + WS_BAR), MISC);

    if (IN(0)) { for (int rep = 0; rep < NREP(0); ++rep) p0_prologue(args, lds, gw, NGW, wave, lane); }
    SEAM(0);
    if (IN(1)) _Pragma("unroll") for (int rep = 0; rep < NREP(1); ++rep) {
        { pg8::Gemm g{XB, (const bf16*)(ws + WS_WGU1), M, 2 * FF, D}; pg8::StaticOrder S; S.init(M, 2 * FF, G, bx);
          pg8::EpiSwiglu E{Hb, FF, ssq}; pg8::gemm_phase<pg8::EpiSwiglu, pg8::StaticOrder, true, true>(lds, g, S, E); }
        { pg8::Gemm g{(const bf16*)(ws + WS_MEMN), (const bf16*)(ws + WS_WKV), NB * NMEM, D, D}; pg8::StaticOrder S; S.init(NB * NMEM, D, G, (bx + G - 128) % G);
          pg8::EpiScale E{(bf16*)(ws + WS_KB), D, nullptr}; pg8::gemm_phase<pg8::EpiScale, pg8::StaticOrder, true, true>(lds, g, S, E); }
        { pg8::Gemm g{(const bf16*)(ws + WS_WKV) + (size_t)D * D, (const bf16*)(ws + WS_MEMN), D, NB * NMEM, D}; pg8::StaticOrder S; S.init(D, NB * NMEM, G, (bx + G - 144) % G);
          pg8::EpiScale E{(bf16*)(ws + WS_VT), NB * NMEM, nullptr}; pg8::gemm_phase<pg8::EpiScale, pg8::StaticOrder, true, true>(lds, g, S, E); }
        if (G == 256 && bx >= 160) p0_items(args, (LAS float*)(lds + wave * 16384), P0_EARLY, P0_MID, (bx - 160) * NWAVES + wave, 96 * NWAVES, lane);
        else if (G != 256) p0_items(args, (LAS float*)(lds + wave * 16384), P0_EARLY, P0_MID, bx * NWAVES + wave, NGW, lane);
    }
    SEAM(1);
    if (IN(2)) {
        pg8::Gemm g{Hb, (const bf16*)(ws + WS_WD1), M, D, FF}; pg8::StaticOrder S; S.init(M, D, G, bx);
        pg8::EpiResid E{nullptr  , XB, ssq + M, 0.5f, nullptr}; pg8::gemm_phase<pg8::EpiResid, pg8::StaticOrder, false, true>(lds, g, S, E);
    }
    SEAM(2);
    if (IN(3)) _Pragma("unroll") for (int rep = 0; rep < NREP(3); ++rep) {
        pg8::Gemm g{XB, (const bf16*)(ws + WS_WIN), M, 2048, D}; pg8::StaticOrder S; S.init(M, 2048, G, bx);
        pg8::EpiWin E{(bf16*)(ws + WS_QS), (bf16*)(ws + WS_VV), (bf16*)(ws + WS_GS), (bf16*)(ws + WS_BC), (bf16*)(ws + WS_CU), (_Float16*)(ws + WS_LF), ssq + M, args.in[I_LB], 0};
        pg8::gemm_phase<pg8::EpiWin, pg8::StaticOrder, true, true>(lds, g, S, E);
    }
    SEAM(3);
    if (IN(4)) _Pragma("unroll") for (int rep = 0; rep < NREP(4); ++rep) {
        const int GA = (G * 3) / 4;
        if (bx < GA) {
            pg8::Gemm g{XB, (const bf16*)(ws + WS_WIN) + (size_t)2048 * D, M, 1536, D}; pg8::StaticOrder S; S.init(M, 1536, GA, bx);
            pg8::EpiWin E{(bf16*)(ws + WS_QS), (bf16*)(ws + WS_VV), (bf16*)(ws + WS_GS), (bf16*)(ws + WS_BC), (bf16*)(ws + WS_CU), (_Float16*)(ws + WS_LF), ssq + M, args.in[I_LB], 8};
            pg8::gemm_phase<pg8::EpiWin, pg8::StaticOrder, true, true>(lds, g, S, E);
        } else {
            for (int qd = bx - GA; qd < 64; qd += G - GA) hg_a2_quad(ws, args.out, lds, qd, tid);
        }
    }
    if (IN(4)) p0_items(args, (LAS float*)(lds + wave * 16384), P0_MID, P0_GU2, gw, NGW, lane);
    SEAM(4);
    if (IN(5)) _Pragma("unroll") for (int rep = 0; rep < NREP(5); ++rep) {
        if (M % (4 * NGW) == 0) { for (int r = gw; r < M; r += 4 * NGW) conv_rows<4>(args, r, NGW, lane); } else { for (int r = gw; r < M; r += NGW) conv_rows<1>(args, r, NGW, lane); }
        for (int u = vcu; u < 256; u += G) hg_c2_unit(args, args.out, lds, u, tid);
    }
    SEAM(5);
    if (IN(7)) {
        pg8::Gemm g{(const bf16*)(ws + WS_MIX), (const bf16*)(ws + WS_WOUT), M, D, D}; pg8::StaticOrder S; S.init(M, D, G, bx);
        pg8::EpiResid E{nullptr, XB, ssq + 2 * M, 1.f, nullptr}; pg8::gemm_phase<pg8::EpiResid, pg8::StaticOrder, false, true>(lds, g, S, E);
    }
    SEAM(7);
    if (IN(8)) _Pragma("unroll") for (int rep = 0; rep < NREP(8); ++rep) {
        pg8::Gemm g{XB, (const bf16*)(ws + WS_WQ), M, D, D}; pg8::StaticOrder S; S.init(M, D, G, bx);
        EpiAttn E{ws, ssq + 2 * M, nullptr}; pg8::gemm_phase<EpiAttn, pg8::StaticOrder, false, true>(lds, g, S, E);
    }
    SEAM(8);
    if (IN(10)) {
        pg8::Gemm g{(const bf16*)(ws + WS_O), (const bf16*)(ws + WS_WO), M, D, D}; pg8::StaticOrder S; S.init(M, D, G, bx);
        pg8::EpiResid E{nullptr, XB, ssq + 3 * M, 1.f, nullptr}; pg8::gemm_phase<pg8::EpiResid, pg8::StaticOrder, false, true>(lds, g, S, E);
    }
    SEAM(10);
    if (IN(11)) _Pragma("unroll") for (int rep = 0; rep < NREP(11); ++rep) {
        pg8::Gemm g{XB, (const bf16*)(ws + WS_WGU2), M, 2 * FF, D}; pg8::StaticOrder S; S.init(M, 2 * FF, G, bx);
        pg8::EpiSwiglu E{Hb, FF, ssq + 3 * M}; pg8::gemm_phase<pg8::EpiSwiglu, pg8::StaticOrder, true, true>(lds, g, S, E);
        if (G == 256 && bx >= 128) p0_items(args, (LAS float*)(lds + wave * 16384), P0_GU2, P0_ALL, (bx - 128) * NWAVES + wave, 128 * NWAVES, lane);
        else if (G != 256) p0_items(args, (LAS float*)(lds + wave * 16384), P0_GU2, P0_ALL, bx * NWAVES + wave, NGW, lane);
    }
    SEAM(11);
    if (IN(12)) {
        pg8::Gemm g{Hb, (const bf16*)(ws + WS_WD2), M, D, FF}; pg8::StaticOrder S; S.init(M, D, G, bx);
        pg8::EpiFinal E{XB, args.out, ssq + 4 * M, (unsigned*)(ws + WS_CNT), args.in[I_FINN], 0.5f}; pg8::gemm_phase<pg8::EpiFinal, pg8::StaticOrder, false, true>(lds, g, S, E);
    }
#undef IN
#undef SEAM
}

#ifndef MK_N_LAUNCHES
#define MK_N_LAUNCHES 1
#endif
extern "C" void kernel_launch(void* const* d_in, const int* in_sizes, int n_in, void* d_out, int out_size, void* d_ws, size_t ws_size, hipStream_t stream) {
    static int grid = 0;
    if (grid == 0) {
        if (n_in != 21 || out_size != M * D || ws_size < WS_END) { fprintf(stderr, "kernel_launch: unexpected problem (n_in %d out %d ws %zu)\n", n_in, out_size, ws_size); grid = -1; return; }
        int dev = 0, cus = 0, per_cu = 0;
        hipGetDevice(&dev); hipDeviceGetAttribute(&cus, hipDeviceAttributeMultiprocessorCount, dev);
        if (hipFuncSetAttribute((const void*)hymba_fwd, hipFuncAttributeMaxDynamicSharedMemorySize, LDS_BYTES) != hipSuccess) { fprintf(stderr, "kernel_launch: hipFuncSetAttribute failed\n"); grid = -1; return; }
        hipOccupancyMaxActiveBlocksPerMultiprocessor(&per_cu, (const void*)hymba_fwd, NT, LDS_BYTES);
        (void)hipGetLastError();
        if (per_cu < 1) per_cu = 1;
        grid = cus * 1;
        if (grid <= 0) grid = 256;
    }
    if (grid < 0) return;
    Args a{};
    for (int i = 0; i < 21; ++i) a.in[i] = (const float*)d_in[i];
    a.out = (float*)d_out; a.ws = (unsigned char*)d_ws;
#if MK_N_LAUNCHES == 1
    if (hipMemsetAsync((char*)d_ws + WS_BAR, 0, BAR_BYTES, stream) != hipSuccess) { fprintf(stderr, "kernel_launch: memset failed\n"); return; }
    a.ph_lo = 0; a.ph_hi = N_PHASES;
    void* kargs[] = {&a};
    hipError_t e = hipLaunchCooperativeKernel((const void*)hymba_fwd, dim3(grid), dim3(NT), kargs, LDS_BYTES, stream);
    if (e != hipSuccess) fprintf(stderr, "cooperative launch failed: %s (grid %d)\n", hipGetErrorString(e), grid);
#else
    for (int p = 0; p < N_PHASES; ++p) { a.ph_lo = p; a.ph_hi = p + 1; hipLaunchKernelGGL(hymba_fwd, dim3(grid), dim3(NT), LDS_BYTES, stream, a); }
#endif
}
```

```cpp
#include <hip/hip_runtime.h>
#include <hip/hip_cooperative_groups.h>
#include <cstdio>
#include <cstdint>
namespace cg = cooperative_groups;
namespace pg8 {
#define PG8_LAS __attribute__((address_space(3)))
typedef unsigned short bf16_t;
typedef short bf16x8 __attribute__((ext_vector_type(8)));
typedef float f32x4 __attribute__((ext_vector_type(4)));
typedef unsigned u32x4 __attribute__((ext_vector_type(4)));
constexpr int BM = 256, BK = 64, HALF = 128, HTB = HALF * BK * 2  , STAGE_BYTES = 8 * HTB, NXCD = 8, WGM = 8;

__host__ __device__ __forceinline__ int lds_byte(int r, int c) { const int st = (r >> 4) * 2 + (c >> 5), rr = r & 15, cc = c & 31, ob = rr * 64 + cc * 2; return st * 1024 + (ob ^ (((ob >> 9) & 1) << 5)); }
__host__ __device__ __forceinline__ void stage_rc(int b, int& R, int& C) { const int st = b / 1024, sb = b % 1024, swz = sb ^ (((sb >> 9) & 1) << 5); R = (st >> 1) * 16 + swz / 64; C = (st & 1) * 32 + (swz % 64) / 2; }
__host__ __device__ __forceinline__ int perm32(int rho) { const int n = rho >> 4, i = rho & 15; return 8 * (i >> 2) + 4 * n + (i & 3); }

struct Unit { int pm, pn; };
struct Gemm { const bf16_t* A; const bf16_t* Bt; int M, N, K; };

struct StaticOrder {
    int nM, nN, nwg, G, c;
    __host__ __device__ void init(int M, int N, int G_, int c_) { nM = M / BM; nN = N / BM; nwg = nM * nN; G = G_; c = c_; }
    __host__ __device__ bool next(int i, Unit& u) const {
        const long L = (long)i * G + c; if (L >= nwg) return false;
        int wgid = (int)L; { const int q = nwg / NXCD, r = nwg % NXCD, xcd = wgid % NXCD, off = wgid / NXCD; wgid = (xcd < r ? xcd * (q + 1) : r * (q + 1) + (xcd - r) * q) + off; }
        const int nig = WGM * nN, gid = wgid / nig, fm = gid * WGM, gsz = (nM - fm) < WGM ? (nM - fm) : WGM;
        u.pm = fm + ((wgid % nig) % gsz); u.pn = (wgid % nig) / gsz; return true;
    }
    __device__ __forceinline__ void a_ready(const Unit&) const {}
    __device__ __forceinline__ void done(const Unit&) const {}
};

typedef float cvf32x2_t __attribute__((ext_vector_type(2))); typedef __bf16 cvbf16x2_t __attribute__((ext_vector_type(2)));
__device__ __forceinline__ unsigned cvt_pk_bf16(float lo, float hi) { cvf32x2_t v = {lo, hi}; cvbf16x2_t b = __builtin_convertvector(v, cvbf16x2_t); return __builtin_bit_cast(unsigned, b); }
typedef float f32x2 __attribute__((ext_vector_type(2)));
typedef unsigned wt_u32x2 __attribute__((ext_vector_type(2)));
#ifndef WT_STORES
#define WT_STORES 0
#endif
__device__ __forceinline__ void st_wt16(void* p, u32x4 v) {
#if WT_STORES
    asm volatile("global_store_dwordx4 %0, %1, off sc1\n\ts_nop 1" :: "v"(p), "v"(v) : "memory");
#else
    *(u32x4*)p = v;
#endif
}
__device__ __forceinline__ void st_wt8(void* p, wt_u32x2 v) {
#if WT_STORES && 0
    asm volatile("global_store_dwordx2 %0, %1, off sc1\n\ts_nop 1" :: "v"(p), "v"(v) : "memory");
#else
    *(wt_u32x2*)p = v;
#endif
}
template <class Epi, class Sched, bool ALIGN_EPI = false, bool SP2 = false>
__device__ __forceinline__ void gemm_phase(PG8_LAS unsigned char* lds, const Gemm g, const Sched& S, const Epi& E) {
    const int tid = threadIdx.x, wid = __builtin_amdgcn_readfirstlane(tid >> 6), lane = tid & 63, wr = wid >> 2, wc = wid & 3, fr = lane & 15, fq = lane >> 4;
    const int K = g.K, nt = K / BK;
    unsigned voffA[2], voffB[2];
#pragma unroll
    for (int i = 0; i < 2; ++i) { int R, C; stage_rc(tid * 16 + i * 8192, R, C); const int Rb = Epi::PERM ? ((R & ~31) + perm32(R & 31)) : R;
        voffA[i] = (unsigned)(R * K + C) * 2u; voffB[i] = (unsigned)(Rb * K + C) * 2u; }
    const size_t kstep = (size_t)(BK * 2);
    const size_t hstep = (size_t)HALF * K * 2;
    const size_t tstep = 2 * hstep;
    const unsigned ldsw = (unsigned)wid * 1024u;
    const int aoff = lds_byte(wr * 64 + fr, fq * 8), boff = lds_byte(wc * 32 + fr, fq * 8);
#define PG8_SA(b, h) (((b) * 2 + (h)) * HTB)
#define PG8_SB(b, h) ((4 + (b) * 2 + (h)) * HTB)
#define PG8_STAGE(bufoff, gbase, voff) do { _Pragma("unroll") for (int _i = 0; _i < 2; ++_i) \
        __builtin_amdgcn_global_load_lds((const unsigned*)((const char*)(gbase) + (voff)[_i]), (PG8_LAS unsigned*)(lds + (bufoff) + ldsw + _i * 8192), 16, 0, 0); } while (0)
#define PG8_LDA(dst, b, h) do { _Pragma("unroll") for (int m = 0; m < 4; ++m) _Pragma("unroll") for (int k = 0; k < 2; ++k) dst[m][k] = *(const PG8_LAS bf16x8*)(lds + PG8_SA(b, h) + aoff + m * 2048 + k * 1024); } while (0)
#define PG8_LDB(dst, b, h) do { _Pragma("unroll") for (int n = 0; n < 2; ++n) _Pragma("unroll") for (int k = 0; k < 2; ++k) dst[n][k] = *(const PG8_LAS bf16x8*)(lds + PG8_SB(b, h) + boff + n * 2048 + k * 1024); } while (0)
#define PG8_MMA(ai, bj, At, Bt) do { __builtin_amdgcn_s_setprio(1); _Pragma("unroll") for (int m = 0; m < 4; ++m) _Pragma("unroll") for (int n = 0; n < 2; ++n) _Pragma("unroll") for (int k = 0; k < 2; ++k) \
        acc[ai][bj][m][n] = __builtin_amdgcn_mfma_f32_16x16x32_bf16(Bt[n][k], At[m][k], acc[ai][bj][m][n], 0, 0, 0); __builtin_amdgcn_s_setprio(0); } while (0)
#define PG8_WAIT_V(n) asm volatile("s_waitcnt vmcnt(" #n ")" ::: "memory")
#define PG8_WAIT_L(n) asm volatile("s_waitcnt lgkmcnt(" #n ")" ::: "memory")
#define PG8_BAR __builtin_amdgcn_s_barrier()
#define PG8_SCHED __builtin_amdgcn_sched_barrier(0)
    Unit cur, nxt; int ui = 0;
    if (!S.next(0, cur)) return;
    f32x4 acc[2][2][4][2];
#pragma unroll
    for (int a = 0; a < 2; ++a)
#pragma unroll
        for (int b = 0; b < 2; ++b)
#pragma unroll
            for (int m = 0; m < 4; ++m)
#pragma unroll
                for (int n = 0; n < 2; ++n) acc[a][b][m][n] = (f32x4){0.f, 0.f, 0.f, 0.f};
    bf16x8 At[4][2], B0[2][2], B1[2][2];
    const char* cA = (const char*)g.A + (size_t)cur.pm * tstep; const char* cB = (const char*)g.Bt + (size_t)cur.pn * tstep;
    S.a_ready(cur);
    if constexpr (SP2) {
        PG8_STAGE(PG8_SB(0, 0), cB, voffB); PG8_STAGE(PG8_SB(0, 1), cB + hstep, voffB); PG8_STAGE(PG8_SA(0, 0), cA, voffA); PG8_STAGE(PG8_SA(0, 1), cA + hstep, voffA);
        if (wr == 1) PG8_BAR;
        PG8_WAIT_V(2); PG8_BAR;
        PG8_STAGE(PG8_SB(1, 0), cB + kstep, voffB); PG8_STAGE(PG8_SA(1, 0), cA + kstep, voffA); PG8_STAGE(PG8_SB(1, 1), cB + hstep + kstep, voffB);
        PG8_WAIT_V(6); PG8_BAR;
    } else {
        PG8_STAGE(PG8_SB(0, 0), cB, voffB); PG8_STAGE(PG8_SA(0, 0), cA, voffA); PG8_STAGE(PG8_SB(0, 1), cB + hstep, voffB); PG8_STAGE(PG8_SA(0, 1), cA + hstep, voffA);
        if (wr == 1) PG8_BAR;
        PG8_WAIT_V(4); PG8_BAR;
        PG8_STAGE(PG8_SB(1, 0), cB + kstep, voffB); PG8_STAGE(PG8_SA(1, 0), cA + kstep, voffA); PG8_STAGE(PG8_SB(1, 1), cB + hstep + kstep, voffB);
        PG8_WAIT_V(6); PG8_BAR;
    }
    for (;;) {
        const bool has_next = S.next(ui + 1, nxt);
        const char* nA = has_next ? (const char*)g.A + (size_t)nxt.pm * tstep : cA; const char* nB = has_next ? (const char*)g.Bt + (size_t)nxt.pn * tstep : cB;
        for (int t = 0; t < nt; t += 2) {
            const bool last = (t == nt - 2);
            const char* a1 = cA + (size_t)(t + 1) * kstep;
            const char* a2 = last ? nA : cA + (size_t)(t + 2) * kstep; const char* b2 = last ? nB : cB + (size_t)(t + 2) * kstep;
            const char* a3 = a2 + kstep; const char* b3 = b2 + kstep;
            if (last && has_next) S.a_ready(nxt);
            if constexpr (SP2) {
            PG8_LDB(B0, 0, 0); PG8_LDB(B1, 0, 1); PG8_SCHED; PG8_LDA(At, 0, 0); PG8_STAGE(PG8_SA(1, 1), a1 + hstep, voffA);
            PG8_WAIT_V(8); PG8_WAIT_L(0); PG8_BAR; PG8_MMA(0, 0, At, B0); PG8_MMA(0, 1, At, B1); PG8_BAR; PG8_SCHED;
            PG8_LDA(At, 0, 1); PG8_STAGE(PG8_SB(0, 0), b2, voffB); PG8_STAGE(PG8_SB(0, 1), b2 + hstep, voffB); PG8_STAGE(PG8_SA(0, 0), a2, voffA);
            PG8_WAIT_V(8); PG8_WAIT_L(0); PG8_BAR; PG8_MMA(1, 0, At, B0); PG8_MMA(1, 1, At, B1); PG8_BAR; PG8_SCHED;
            PG8_LDB(B0, 1, 0); PG8_LDB(B1, 1, 1); PG8_SCHED; PG8_LDA(At, 1, 0); PG8_STAGE(PG8_SA(0, 1), a2 + hstep, voffA);
            PG8_WAIT_V(8); PG8_WAIT_L(0); PG8_BAR; PG8_MMA(0, 0, At, B0); PG8_MMA(0, 1, At, B1); PG8_BAR; PG8_SCHED;
            PG8_LDA(At, 1, 1); PG8_STAGE(PG8_SB(1, 0), b3, voffB); PG8_STAGE(PG8_SB(1, 1), b3 + hstep, voffB); PG8_STAGE(PG8_SA(1, 0), a3, voffA);
            PG8_WAIT_V(8); PG8_WAIT_L(0); PG8_BAR; PG8_MMA(1, 0, At, B0); PG8_MMA(1, 1, At, B1); PG8_BAR; PG8_SCHED;
            } else {
            PG8_LDB(B0, 0, 0); PG8_SCHED; PG8_LDA(At, 0, 0); PG8_STAGE(PG8_SA(1, 1), a1 + hstep, voffA);
            PG8_WAIT_L(8); PG8_BAR; PG8_WAIT_L(0); PG8_MMA(0, 0, At, B0); PG8_BAR; PG8_SCHED;
            PG8_LDB(B1, 0, 1); PG8_STAGE(PG8_SB(0, 0), b2, voffB);
            PG8_BAR; PG8_WAIT_L(0); PG8_MMA(0, 1, At, B1); PG8_BAR;
            PG8_LDA(At, 0, 1); PG8_STAGE(PG8_SA(0, 0), a2, voffA);
            PG8_BAR; PG8_WAIT_L(0); PG8_MMA(1, 0, At, B0); PG8_BAR; PG8_SCHED;
            PG8_STAGE(PG8_SB(0, 1), b2 + hstep, voffB);
            PG8_WAIT_V(6); PG8_BAR; PG8_MMA(1, 1, At, B1); PG8_BAR;
            PG8_LDB(B0, 1, 0); PG8_SCHED; PG8_LDA(At, 1, 0); PG8_STAGE(PG8_SA(0, 1), a2 + hstep, voffA);
            PG8_WAIT_L(8); PG8_BAR; PG8_WAIT_L(0); PG8_MMA(0, 0, At, B0); PG8_BAR; PG8_SCHED;
            PG8_LDB(B1, 1, 1); PG8_STAGE(PG8_SB(1, 0), b3, voffB);
            PG8_BAR; PG8_WAIT_L(0); PG8_MMA(0, 1, At, B1); PG8_BAR;
            PG8_LDA(At, 1, 1); PG8_STAGE(PG8_SA(1, 0), a3, voffA);
            PG8_BAR; PG8_WAIT_L(0); PG8_MMA(1, 0, At, B0); PG8_BAR; PG8_SCHED;
            PG8_STAGE(PG8_SB(1, 1), b3 + hstep, voffB);
            PG8_WAIT_V(6); PG8_BAR; PG8_MMA(1, 1, At, B1); PG8_BAR;
            }
        }
        if constexpr (ALIGN_EPI) { if (wr == 0) PG8_BAR; }
        if constexpr (!Epi::AFTER_DRAIN) { E(acc, cur, wr, wc, fr, fq); S.done(cur); }
        if (!has_next) break;
#pragma unroll
        for (int a = 0; a < 2; ++a)
#pragma unroll
            for (int b = 0; b < 2; ++b)
#pragma unroll
                for (int m = 0; m < 4; ++m)
#pragma unroll
                    for (int n = 0; n < 2; ++n) acc[a][b][m][n] = (f32x4){0.f, 0.f, 0.f, 0.f};
        cur = nxt; cA = nA; cB = nB; ++ui;
        if constexpr (ALIGN_EPI) { if (wr == 1) PG8_BAR; }
    }
    PG8_WAIT_V(0);
    if constexpr (!ALIGN_EPI) { if (wr == 0) PG8_BAR; }
    PG8_BAR;
    if constexpr (Epi::AFTER_DRAIN) { E.fused(acc, cur, wr, wc, fr, fq, lds, wid, lane); S.done(cur); }
#undef PG8_SA
#undef PG8_SB
#undef PG8_STAGE
#undef PG8_LDA
#undef PG8_LDB
#undef PG8_MMA
#undef PG8_WAIT_V
#undef PG8_WAIT_L
#undef PG8_BAR
#undef PG8_SCHED
}
}
namespace pg8 {
typedef unsigned u32x2 __attribute__((ext_vector_type(2)));
typedef _Float16 f16x4 __attribute__((ext_vector_type(4)));
constexpr float RMS_EPS = 1e-6f;
__device__ __forceinline__ float fsigm(float x) { return __builtin_amdgcn_rcpf(1.f + __expf(-x)); }
__device__ __forceinline__ float fsilu(float x) { return x * fsigm(x); }
__device__ __forceinline__ float row_rs(const float* ssq, int row) { return ssq ? rsqrtf(ssq[row] * (1.f / 1024.f) + RMS_EPS) : 1.f; }

struct EpiSwiglu {
    static constexpr bool PERM = true, AFTER_DRAIN = false;
    bf16_t* H; int ldh; const float* ssq;
    __device__ __forceinline__ void operator()(const f32x4 (&acc)[2][2][4][2], const Unit& u, int wr, int wc, int fr, int fq) const {
        const int row0 = u.pm * BM + wr * 64 + fr, col0 = u.pn * HALF + wc * 32 + 8 * fq;
#pragma unroll
        for (int ai = 0; ai < 2; ++ai)
#pragma unroll
            for (int m = 0; m < 4; ++m) { const int row = row0 + ai * HALF + m * 16; const float rs = row_rs(ssq, row);
                u32x4 w; unsigned pk[4];
#pragma unroll
                for (int n = 0; n < 2; ++n) { const f32x4 g = acc[ai][0][m][n] * rs, up = acc[ai][1][m][n] * rs;
                    pk[2 * n] = cvt_pk_bf16(fsilu(g[0]) * up[0], fsilu(g[1]) * up[1]); pk[2 * n + 1] = cvt_pk_bf16(fsilu(g[2]) * up[2], fsilu(g[3]) * up[3]); }
                w.x = pk[0]; w.y = pk[1]; w.z = pk[2]; w.w = pk[3];
                st_wt16(H + (size_t)row * ldh + col0, w); }
    }
};
struct EpiScale {
    static constexpr bool PERM = true, AFTER_DRAIN = false;
    bf16_t* O; int ldc; const float* ssq;
    __device__ __forceinline__ void operator()(const f32x4 (&acc)[2][2][4][2], const Unit& u, int wr, int wc, int fr, int fq) const {
        const int row0 = u.pm * BM + wr * 64 + fr, col0 = u.pn * BM + wc * 32 + 8 * fq;
#pragma unroll
        for (int ai = 0; ai < 2; ++ai)
#pragma unroll
            for (int m = 0; m < 4; ++m) { const int row = row0 + ai * HALF + m * 16; const float rs = row_rs(ssq, row);
#pragma unroll
                for (int bj = 0; bj < 2; ++bj) { const f32x4 v0 = acc[ai][bj][m][0] * rs, v1 = acc[ai][bj][m][1] * rs; u32x4 w;
                    w.x = cvt_pk_bf16(v0[0], v0[1]); w.y = cvt_pk_bf16(v0[2], v0[3]); w.z = cvt_pk_bf16(v1[0], v1[1]); w.w = cvt_pk_bf16(v1[2], v1[3]);
                    st_wt16(O + (size_t)row * ldc + col0 + bj * HALF, w); } }
    }
};
__device__ __forceinline__ void panel_sync(unsigned* cnt, int pm, int wid, int lane) {
    asm volatile("s_waitcnt vmcnt(0) lgkmcnt(0)" ::: "memory"); __builtin_amdgcn_s_barrier(); asm volatile("" ::: "memory");
    if (wid == 0) {
        if (lane == 0) { __builtin_amdgcn_fence(__ATOMIC_RELEASE, "agent"); asm volatile("s_waitcnt vmcnt(0)" ::: "memory"); __hip_atomic_fetch_add(cnt + 64 * pm, 1u, __ATOMIC_RELAXED, __HIP_MEMORY_SCOPE_AGENT); }
        unsigned sp = 0;
        while ((unsigned)__builtin_amdgcn_readfirstlane(__hip_atomic_load(cnt + 64 * pm, __ATOMIC_RELAXED, __HIP_MEMORY_SCOPE_AGENT)) < 4u) { __builtin_amdgcn_s_sleep(2); if (++sp > (1u << 22)) break; }
        __builtin_amdgcn_fence(__ATOMIC_ACQUIRE, "agent");
        asm volatile("s_waitcnt vmcnt(0)" ::: "memory");
    }
    asm volatile("" ::: "memory"); __builtin_amdgcn_s_barrier(); asm volatile("" ::: "memory");
}
__device__ __forceinline__ float bfl(unsigned w) { return __uint_as_float(w << 16); }
__device__ __forceinline__ float bfh(unsigned w) { return __uint_as_float(w & 0xffff0000u); }
struct EpiResid {
    static constexpr bool PERM = true, AFTER_DRAIN = true;
    const float* xin32; bf16_t* xb; float* ssq_out; float scale; unsigned* psync;
    __device__ __forceinline__ void fused(f32x4 (&acc)[2][2][4][2], const Unit& u, int wr, int wc, int fr, int fq, PG8_LAS unsigned char* lds, int wid, int lane) const {
        PG8_LAS float* P = (PG8_LAS float*)lds;
        const int row0 = u.pm * BM + wr * 64 + fr, col0 = u.pn * BM + wc * 32 + 8 * fq;
#pragma unroll
        for (int ai = 0; ai < 2; ++ai)
#pragma unroll
            for (int m = 0; m < 4; ++m) { const int row = row0 + ai * HALF + m * 16; const size_t off = (size_t)row * 1024 + col0; float ss = 0.f;
#pragma unroll
                for (int bj = 0; bj < 2; ++bj) { const size_t o = off + bj * HALF; f32x4 x0, x1;
                    if (xin32) { x0 = *(const f32x4*)(xin32 + o); x1 = *(const f32x4*)(xin32 + o + 4); }
                    else { const u32x4 w = *(const u32x4*)(xb + o); x0 = (f32x4){bfl(w.x), bfh(w.x), bfl(w.y), bfh(w.y)}; x1 = (f32x4){bfl(w.z), bfh(w.z), bfl(w.w), bfh(w.w)}; }
                    const f32x4 v0 = x0 + acc[ai][bj][m][0] * scale, v1 = x1 + acc[ai][bj][m][1] * scale;
                    ss += ((v0[0] * v0[0] + v0[1] * v0[1]) + (v0[2] * v0[2] + v0[3] * v0[3])) + ((v1[0] * v1[0] + v1[1] * v1[1]) + (v1[2] * v1[2] + v1[3] * v1[3]));
                    u32x4 w; w.x = cvt_pk_bf16(v0[0], v0[1]); w.y = cvt_pk_bf16(v0[2], v0[3]); w.z = cvt_pk_bf16(v1[0], v1[1]); w.w = cvt_pk_bf16(v1[2], v1[3]); st_wt16(xb + o, w); }
                ss += __shfl_xor(ss, 16); ss += __shfl_xor(ss, 32);
                if (fq == 0) P[(ai * HALF + wr * 64 + m * 16 + fr) * 4 + wc] = ss; }
        asm volatile("s_waitcnt lgkmcnt(0)" ::: "memory"); __builtin_amdgcn_s_barrier(); asm volatile("" ::: "memory");
        const int t = wid * 64 + lane;
        if (t < 256) { const f32x4 p = *(const PG8_LAS f32x4*)(P + t * 4); unsafeAtomicAdd(ssq_out + u.pm * BM + t, (p[0] + p[1]) + (p[2] + p[3])); }
        asm volatile("s_waitcnt lgkmcnt(0)" ::: "memory"); __builtin_amdgcn_s_barrier(); asm volatile("" ::: "memory");
        if (psync) panel_sync(psync, u.pm, wid, lane);
    }
};
struct EpiFinal {
    static constexpr bool PERM = true, AFTER_DRAIN = true;
    const bf16_t* xb; float* out; float* ssq; unsigned* cnt; const float* gain; float scale;
    __device__ __forceinline__ void fused(f32x4 (&acc)[2][2][4][2], const Unit& u, int wr, int wc, int fr, int fq, PG8_LAS unsigned char* lds, int wid, int lane) const {
        PG8_LAS float* P = (PG8_LAS float*)lds;
        const int row0 = u.pm * BM + wr * 64 + fr, col0 = u.pn * BM + wc * 32 + 8 * fq;
#pragma unroll
        for (int ai = 0; ai < 2; ++ai)
#pragma unroll
            for (int m = 0; m < 4; ++m) { const int row = row0 + ai * HALF + m * 16; const size_t off = (size_t)row * 1024 + col0; float ss = 0.f;
#pragma unroll
                for (int bj = 0; bj < 2; ++bj) { const u32x4 w = *(const u32x4*)(xb + off + bj * HALF);
                    const f32x4 x0 = {bfl(w.x), bfh(w.x), bfl(w.y), bfh(w.y)}, x1 = {bfl(w.z), bfh(w.z), bfl(w.w), bfh(w.w)};
                    const f32x4 v0 = x0 + acc[ai][bj][m][0] * scale, v1 = x1 + acc[ai][bj][m][1] * scale; acc[ai][bj][m][0] = v0; acc[ai][bj][m][1] = v1;
                    ss += ((v0[0] * v0[0] + v0[1] * v0[1]) + (v0[2] * v0[2] + v0[3] * v0[3])) + ((v1[0] * v1[0] + v1[1] * v1[1]) + (v1[2] * v1[2] + v1[3] * v1[3])); }
                ss += __shfl_xor(ss, 16); ss += __shfl_xor(ss, 32);
                if (fq == 0) P[(ai * HALF + wr * 64 + m * 16 + fr) * 4 + wc] = ss; }
        asm volatile("s_waitcnt lgkmcnt(0)" ::: "memory"); __builtin_amdgcn_s_barrier(); asm volatile("" ::: "memory");
        const int t = wid * 64 + lane;
        if (t < 256) { const f32x4 p = *(const PG8_LAS f32x4*)(P + t * 4); unsafeAtomicAdd(ssq + u.pm * BM + t, (p[0] + p[1]) + (p[2] + p[3])); }
        asm volatile("s_waitcnt vmcnt(0) lgkmcnt(0)" ::: "memory"); __builtin_amdgcn_s_barrier(); asm volatile("" ::: "memory");
        if (wid == 0) {
            if (lane == 0) __hip_atomic_fetch_add(cnt + 64 * u.pm, 1u, __ATOMIC_RELAXED, __HIP_MEMORY_SCOPE_AGENT);
            unsigned sp = 0;
            while ((unsigned)__builtin_amdgcn_readfirstlane(__hip_atomic_load(cnt + 64 * u.pm, __ATOMIC_RELAXED, __HIP_MEMORY_SCOPE_AGENT)) < 4u) { __builtin_amdgcn_s_sleep(2); if (++sp > (1u << 22)) break; }
        }
        asm volatile("s_waitcnt vmcnt(0) lgkmcnt(0)" ::: "memory"); __builtin_amdgcn_s_barrier(); asm volatile("" ::: "memory");
#pragma unroll
        for (int ai = 0; ai < 2; ++ai)
#pragma unroll
            for (int m = 0; m < 4; ++m) { const int row = row0 + ai * HALF + m * 16; const size_t off = (size_t)row * 1024 + col0;
                const float rs = rsqrtf(__hip_atomic_load(ssq + row, __ATOMIC_RELAXED, __HIP_MEMORY_SCOPE_AGENT) * (1.f / 1024.f) + RMS_EPS);
#pragma unroll
                for (int bj = 0; bj < 2; ++bj)
#pragma unroll
                    for (int n = 0; n < 2; ++n) { const f32x4 g = *(const f32x4*)(gain + col0 + bj * HALF + n * 4); *(f32x4*)(out + off + bj * HALF + n * 4) = acc[ai][bj][m][n] * rs * g; } }
    }
};
struct EpiWin {
    static constexpr bool PERM = true, AFTER_DRAIN = false;
    bf16_t *QS, *VV, *GS, *BC, *CU; _Float16* LF; const float* ssq; const float* lbl; int pn0;
    __device__ __forceinline__ void operator()(const f32x4 (&acc)[2][2][4][2], const Unit& u, int wr, int wc, int fr, int fq) const {
        const int row0 = u.pm * BM + wr * 64 + fr; const int pn = u.pn + pn0; const int cw = wc * 32 + 8 * fq;
        if (pn >= 10) {
#pragma unroll
            for (int ai = 0; ai < 2; ++ai)
#pragma unroll
                for (int m = 0; m < 4; ++m) { const int row = row0 + ai * HALF + m * 16; const float rs = row_rs(ssq, row); const float rs2 = rs * rs;
                    const f32x4 v0 = acc[ai][0][m][0] * acc[ai][1][m][0] * rs2, v1 = acc[ai][0][m][1] * acc[ai][1][m][1] * rs2; u32x4 w;
                    w.x = cvt_pk_bf16(v0[0], v0[1]); w.y = cvt_pk_bf16(v0[2], v0[3]); w.z = cvt_pk_bf16(v1[0], v1[1]); w.w = cvt_pk_bf16(v1[2], v1[3]);
                    *(u32x4*)(CU + (size_t)row * 512 + (pn - 10) * HALF + cw) = w; }
            return;
        }
        const int grp = pn >> 1;
        const int cbase = (pn & 1) * BM + cw;
        if (grp == 1) {
            float lb[2][2][4];
#pragma unroll
            for (int bj = 0; bj < 2; ++bj)
#pragma unroll
                for (int n = 0; n < 2; ++n) { const int c = cbase + bj * HALF + n * 4; const f32x4 l0 = *(const f32x4*)(lbl + c), l1 = *(const f32x4*)(lbl + 512 + c);
#pragma unroll
                    for (int j = 0; j < 4; ++j) lb[bj][n][j] = fsigm(l0[j] - l1[j]); }
#pragma unroll
            for (int ai = 0; ai < 2; ++ai)
#pragma unroll
                for (int m = 0; m < 4; ++m) { const int row = row0 + ai * HALF + m * 16; const float rs = row_rs(ssq, row);
#pragma unroll
                    for (int bj = 0; bj < 2; ++bj) { f16x4 o[2];
#pragma unroll
                        for (int n = 0; n < 2; ++n) { const f32x4 p = acc[ai][bj][m][n] * rs;
#pragma unroll
                            for (int j = 0; j < 4; ++j) { const float l = lb[bj][n][j]; const float f = l + (1.f - l) * fsigm(p[j]); o[n][j] = (_Float16)__logf(f); } }
                        const u32x2 a0 = __builtin_bit_cast(u32x2, o[0]), a1 = __builtin_bit_cast(u32x2, o[1]); u32x4 w; w.x = a0.x; w.y = a0.y; w.z = a1.x; w.w = a1.y;
                        *(u32x4*)(LF + (size_t)row * 512 + cbase + bj * HALF) = w; } }
            return;
        }
        bf16_t* dst = grp == 0 ? QS : (grp == 2 ? VV : (grp == 3 ? GS : BC)); const bool act = (grp == 0) || (grp == 3);
#pragma unroll
        for (int ai = 0; ai < 2; ++ai)
#pragma unroll
            for (int m = 0; m < 4; ++m) { const int row = row0 + ai * HALF + m * 16; const float rs = row_rs(ssq, row);
#pragma unroll
                for (int bj = 0; bj < 2; ++bj) { f32x4 p0 = acc[ai][bj][m][0] * rs, p1 = acc[ai][bj][m][1] * rs;
                    if (act) { p0[0] = fsilu(p0[0]); p0[1] = fsilu(p0[1]); p0[2] = fsilu(p0[2]); p0[3] = fsilu(p0[3]); p1[0] = fsilu(p1[0]); p1[1] = fsilu(p1[1]); p1[2] = fsilu(p1[2]); p1[3] = fsilu(p1[3]); }
                    u32x4 w; w.x = cvt_pk_bf16(p0[0], p0[1]); w.y = cvt_pk_bf16(p0[2], p0[3]); w.z = cvt_pk_bf16(p1[0], p1[1]); w.w = cvt_pk_bf16(p1[2], p1[3]);
                    *(u32x4*)(dst + (size_t)row * 512 + cbase + bj * HALF) = w; } }
    }
};
}
#define LAS __attribute__((address_space(3)))
typedef unsigned short bf16;
typedef unsigned v4u __attribute__((ext_vector_type(4)));
typedef unsigned v2u __attribute__((ext_vector_type(2)));
typedef float f32x4 __attribute__((ext_vector_type(4)));
typedef float f32x16 __attribute__((ext_vector_type(16)));
typedef short bf16x8 __attribute__((ext_vector_type(8)));
typedef short s16x4 __attribute__((ext_vector_type(4)));
constexpr int NWAVES = 8, NT = NWAVES * 64;
constexpr int M = 16384, D = 1024, FF = 2816, IC = 3584, SEQ = 4096, NB = 4, NMEM = 256;
constexpr float EPS = 1e-6f;
constexpr size_t MiB = 1u << 20;
constexpr size_t WS_SSQ = 0;
constexpr size_t WS_DEC = 512 * 1024;
constexpr size_t WS_WGU1 = 1 * MiB, WS_WD1 = 12 * MiB, WS_WIN = 18 * MiB, WS_WOUT = 25 * MiB, WS_WQ = 27 * MiB, WS_WKV = 29 * MiB, WS_WO = 33 * MiB, WS_WGU2 = 35 * MiB, WS_WD2 = 46 * MiB;
constexpr size_t WS_XB = 54 * MiB;
constexpr size_t WS_KB = 86 * MiB, WS_VT = 88 * MiB, WS_MEMN = 90 * MiB;
constexpr size_t WS_R = 96 * MiB;
constexpr size_t WS_H = WS_R;
constexpr size_t WS_QS = WS_R, WS_LF = WS_R + 16 * MiB, WS_VV = WS_R + 32 * MiB, WS_GS = WS_R + 48 * MiB, WS_BC = WS_R + 64 * MiB, WS_CU = WS_R + 80 * MiB;
constexpr size_t WS_ST = WS_R + 96 * MiB, WS_MIX = WS_R + 128 * MiB;
constexpr size_t WS_O = WS_ST;
constexpr size_t WS_END = 256 * MiB;
static_assert(WS_WD2 + (size_t)D * FF * 2 <= WS_XB && WS_MIX + (size_t)M * D * 2 <= WS_END && WS_H + (size_t)M * FF * 2 <= WS_END, "ws map");
constexpr int LDS_BYTES = 147456;
constexpr int MISC_OFF = LDS_BYTES - 64;
constexpr size_t WS_BAR = 400 * 1024, WS_CNT = WS_BAR + 16384, BAR_BYTES = 65536 + 4096;

__device__ __forceinline__ unsigned pk2(float lo, float hi) { return pg8::cvt_pk_bf16(lo, hi); }
__device__ __forceinline__ float bf2f(unsigned short u) { return __uint_as_float((unsigned)u << 16); }
__device__ __forceinline__ float wave_sum(float v) {
#pragma unroll
    for (int o = 1; o < 64; o <<= 1) v += __shfl_xor(v, o);
    return v;
}
#define LDS_WAIT() asm volatile("s_waitcnt lgkmcnt(0)" ::: "memory")
#define LBAR() do { asm volatile("s_waitcnt lgkmcnt(0)" ::: "memory"); __builtin_amdgcn_s_barrier(); asm volatile("" ::: "memory"); } while (0)

__device__ __forceinline__ int rowmap(int mode, int n0, int N) {
    if (mode == 1) { const int half = N / 2, isup = n0 >= half ? 1 : 0, j = n0 - isup * half; return (j / 128) * 256 + isup * 128 + (j % 128); }
    if (mode == 2) { if (n0 < 2560) return n0; int j = n0 - 2560; const int isu = j >= 512 ? 1 : 0; j -= isu * 512; return 2560 + (j / 128) * 256 + isu * 128 + (j % 128); }
    return n0;
}
struct P0Desc { const float* W; bf16* WT; const float* gain; float scale; int K, N, mode, item; };
__device__ __forceinline__ void p0_load(const P0Desc& d, float (&v)[32], int lane) {
    const int nblk = d.N / 32, kb = d.item / nblk, nb = d.item % nblk, k0 = 64 * kb, n0 = 32 * nb;
    const float* p = d.W + (size_t)(k0 + (lane >> 5)) * d.N + n0 + (lane & 31);
#pragma unroll
    for (int i = 0; i < 32; ++i) v[i] = __builtin_nontemporal_load(p + (size_t)(2 * i) * d.N);
}
__device__ __forceinline__ void p0_store(const P0Desc& d, const float (&v)[32], LAS float* scr, int lane) {
    const int nblk = d.N / 32, kb = d.item / nblk, nb = d.item % nblk, k0 = 64 * kb, n0 = 32 * nb;
#pragma unroll
    for (int i = 0; i < 32; ++i) scr[(2 * i + (lane >> 5)) * 33 + (lane & 31)] = v[i];
    LDS_WAIT(); asm volatile("" ::: "memory");
    const int c = lane & 7; const int r0 = rowmap(d.mode, n0, d.N);
    f32x4 g0 = {d.scale, d.scale, d.scale, d.scale}, g1 = g0;
    if (d.gain) { g0 = *(const f32x4*)(d.gain + k0 + 8 * c) * d.scale; g1 = *(const f32x4*)(d.gain + k0 + 8 * c + 4) * d.scale; }
#pragma unroll
    for (int j = 0; j < 4; ++j) { const int n = (lane >> 3) + 8 * j; const LAS float* q = scr + (8 * c) * 33 + n;
        v4u o; o.x = pk2(q[0 * 33] * g0[0], q[1 * 33] * g0[1]); o.y = pk2(q[2 * 33] * g0[2], q[3 * 33] * g0[3]); o.z = pk2(q[4 * 33] * g1[0], q[5 * 33] * g1[1]); o.w = pk2(q[6 * 33] * g1[2], q[7 * 33] * g1[3]);
        pg8::st_wt16(d.WT + (size_t)(r0 + n) * d.K + k0 + 8 * c, o); }
    LDS_WAIT(); asm volatile("" ::: "memory");
}

struct Args { const float* in[21]; float* out; unsigned char* ws; int ph_lo, ph_hi; };
enum { I_X = 0, I_MEM, I_F1N, I_F1GU, I_F1D, I_MIXN, I_WIN, I_LB, I_HGN, I_CONVW, I_CONVN, I_WOUT, I_XAN, I_MEMNORM, I_WQ, I_WKV, I_WO, I_F2N, I_F2GU, I_F2D, I_FINN };

struct P0Tab { int in_w, in_g, K, N, mode, first; float scale; unsigned pad; unsigned long long wt_off; };
constexpr int PI_GU = (D / 64) * (2 * FF / 32), PI_DN = (FF / 64) * (D / 32), PI_IN = (D / 64) * (IC / 32), PI_SQ = (D / 64) * (D / 32), PI_KV = (D / 64) * (2 * D / 32);
__device__ const P0Tab P0TAB[9] = {
    {I_F1GU, I_F1N, D, 2 * FF, 1, 0, 1.f, 0u, WS_WGU1},
    {I_WKV, -1, D, 2 * D, 0, PI_GU, 1.f, 0u, WS_WKV},
    {I_F1D, -1, FF, D, 0, PI_GU + PI_KV, 1.f, 0u, WS_WD1},
    {I_WIN, I_MIXN, D, IC, 2, PI_GU + PI_KV + PI_DN, 1.f, 0u, WS_WIN},
    {I_WOUT, -1, D, D, 0, PI_GU + PI_KV + PI_DN + PI_IN, 1.f, 0u, WS_WOUT},
    {I_WQ, I_XAN, D, D, 0, PI_GU + PI_KV + PI_DN + PI_IN + PI_SQ, 0.0625f, 0u, WS_WQ},
    {I_WO, -1, D, D, 0, PI_GU + PI_KV + PI_DN + PI_IN + 2 * PI_SQ, 1.f, 0u, WS_WO},
    {I_F2GU, I_F2N, D, 2 * FF, 1, PI_GU + PI_KV + PI_DN + PI_IN + 3 * PI_SQ, 1.f, 0u, WS_WGU2},
    {I_F2D, -1, FF, D, 0, 2 * PI_GU + PI_KV + PI_DN + PI_IN + 3 * PI_SQ, 1.f, 0u, WS_WD2},
};
constexpr int P0_EARLY = PI_GU + PI_KV, P0_MID = PI_GU + PI_KV + PI_DN + PI_IN + 3 * PI_SQ, P0_GU2 = P0_MID + PI_GU, P0_ALL = P0_GU2 + PI_DN;

__device__ __forceinline__ void p0_items(const Args& a, LAS float* scr, int first, int last, int w, int nw, int lane) {
    unsigned char* ws = a.ws;
    auto desc = [&](int it) -> P0Desc {
        int mi = 0;
#pragma unroll
        for (int j = 1; j < 9; ++j) mi += (it >= P0TAB[j].first) ? 1 : 0;
        const P0Tab t = P0TAB[mi];
        P0Desc d; d.W = a.in[t.in_w]; d.WT = (bf16*)(ws + t.wt_off); d.gain = t.in_g >= 0 ? a.in[t.in_g] : nullptr; d.scale = t.scale; d.K = t.K; d.N = t.N; d.mode = t.mode; d.item = it - t.first;
        return d;
    };
    float va[32], vb[32]; int it = first + w;
    P0Desc da = desc(it < last ? it : first), db = da;
    if (it < last) p0_load(da, va, lane);
    while (it < last) {
        const int n1 = it + nw; if (n1 < last) { db = desc(n1); p0_load(db, vb, lane); }
        p0_store(da, va, scr, lane);
        if (n1 >= last) break;
        const int n2 = n1 + nw; if (n2 < last) { da = desc(n2); p0_load(da, va, lane); }
        p0_store(db, vb, scr, lane);
        it = n2;
    }
}
__device__ __forceinline__ void p0_prologue(const Args& a, LAS unsigned char* lds, int gw, int NGW, int wave, int lane) {
    unsigned char* ws = a.ws;
    LAS float* scr = (LAS float*)(lds + wave * 16384);
    p0_items(a, scr, 0, P0_EARLY, gw, NGW, lane);
    float* ssq = (float*)(ws + WS_SSQ);
    for (int m = gw; m < M; m += 2 * NGW) {
        const int m1 = m + NGW;
        const f32x4* xr0 = (const f32x4*)(a.in[I_X] + (size_t)m * D) + lane; const f32x4* xr1 = (const f32x4*)(a.in[I_X] + (size_t)(m1 < M ? m1 : m) * D) + lane; f32x4 v[4], w4[4]; float s = 0.f, s1 = 0.f;
#pragma unroll
        for (int j = 0; j < 4; ++j) { v[j] = __builtin_nontemporal_load(xr0 + 64 * j); w4[j] = __builtin_nontemporal_load(xr1 + 64 * j); }
#pragma unroll
        for (int j = 0; j < 4; ++j) { s += (v[j][0] * v[j][0] + v[j][1] * v[j][1]) + (v[j][2] * v[j][2] + v[j][3] * v[j][3]); s1 += (w4[j][0] * w4[j][0] + w4[j][1] * w4[j][1]) + (w4[j][2] * w4[j][2] + w4[j][3] * w4[j][3]); }
        s = wave_sum(s); s1 = wave_sum(s1); if (lane == 0) { ssq[m] = s; if (m1 < M) ssq[m1] = s1; }
        v2u* o = (v2u*)((bf16*)(ws + WS_XB) + (size_t)m * D) + lane;
#pragma unroll
        for (int j = 0; j < 4; ++j) { v2u w; w.x = pk2(v[j][0], v[j][1]); w.y = pk2(v[j][2], v[j][3]); o[64 * j] = w; }
        if (m1 < M) { v2u* o1 = (v2u*)((bf16*)(ws + WS_XB) + (size_t)m1 * D) + lane;
#pragma unroll
            for (int j = 0; j < 4; ++j) { v2u w; w.x = pk2(w4[j][0], w4[j][1]); w.y = pk2(w4[j][2], w4[j][3]); o1[64 * j] = w; } }
    }
    for (int m = gw; m < NB * NMEM; m += NGW) {
        const f32x4* xr = (const f32x4*)(a.in[I_MEM] + (size_t)m * D) + lane; const f32x4* gr = (const f32x4*)(a.in[I_MEMNORM]) + lane; f32x4 v[4]; float s = 0.f;
#pragma unroll
        for (int j = 0; j < 4; ++j) { v[j] = xr[64 * j]; s += (v[j][0] * v[j][0] + v[j][1] * v[j][1]) + (v[j][2] * v[j][2] + v[j][3] * v[j][3]); }
        s = wave_sum(s); const float rs = rsqrtf(s * (1.f / D) + EPS);
        v2u* o = (v2u*)((bf16*)(ws + WS_MEMN) + (size_t)m * D) + lane;
#pragma unroll
        for (int j = 0; j < 4; ++j) { const f32x4 g = gr[64 * j]; v2u w; w.x = pk2(v[j][0] * rs * g[0], v[j][1] * rs * g[1]); w.y = pk2(v[j][2] * rs * g[2], v[j][3] * rs * g[3]); o[64 * j] = w; }
    }
    for (int i = gw * 64 + lane; i < 4 * M; i += NGW * 64) ssq[M + i] = 0.f;
}

constexpr int GP = 264;
__device__ __forceinline__ void hg_a2_quad(unsigned char* ws, float* Gp, LAS unsigned char* lds, int quad, int tid) {
    const int k = tid & 127, seg = tid >> 7, lane = tid & 63, wave = tid >> 6, l15 = lane & 15, lq = lane >> 4;
    LAS float* segsum = (LAS float*)lds;
    LAS float* dl = (LAS float*)(lds + 2048);
    LAS bf16* KPt = (LAS bf16*)(lds + 2560);
    LAS bf16* Vt = KPt + 128 * GP;
    f32x4 R[8];
#pragma unroll
    for (int kt = 0; kt < 8; ++kt) R[kt] = (f32x4){0.f, 0.f, 0.f, 0.f};
#pragma unroll 1
    for (int gi = 0; gi < 4; ++gi) {
        const int unit = quad * 4 + gi, bh = unit >> 4, g = unit & 15, b = bh >> 2, h = bh & 3, row0 = b * SEQ + g * 256;
        const size_t gofs = (size_t)(row0 + seg * 64) * 512 + h * 128 + k;
        const _Float16* lfp = (const _Float16*)(ws + WS_LF) + gofs; const bf16* vp = (const bf16*)(ws + WS_VV) + gofs;
        float lf[64]; unsigned vq[32];
#pragma unroll
        for (int i = 0; i < 64; ++i) lf[i] = (float)__builtin_nontemporal_load(lfp + (size_t)i * 512);
#pragma unroll
        for (int i = 0; i < 32; ++i) vq[i] = (unsigned)__builtin_nontemporal_load(vp + (size_t)(2 * i) * 512) | ((unsigned)__builtin_nontemporal_load(vp + (size_t)(2 * i + 1) * 512) << 16);
        if (gi > 0) { float* pp = Gp + (size_t)unit * 16384 + (size_t)(wave * 8) * 256 + lane * 4;
#pragma unroll
            for (int kt = 0; kt < 8; ++kt) *(f32x4*)(pp + kt * 256) = R[kt]; }
        float run = 0.f;
#pragma unroll
        for (int i = 0; i < 64; ++i) run += lf[i];
        segsum[seg * 128 + k] = run;
#pragma unroll
        for (int i = 0; i < 8; ++i) *(LAS v4u*)(Vt + k * GP + seg * 64 + 8 * i) = (v4u){vq[4 * i], vq[4 * i + 1], vq[4 * i + 2], vq[4 * i + 3]};
        LBAR();
        const float s0 = segsum[k], s1 = segsum[128 + k], s2 = segsum[256 + k], s3 = segsum[384 + k];
        const float pre = (seg > 0 ? s0 : 0.f) + (seg > 1 ? s1 : 0.f) + (seg > 2 ? s2 : 0.f);
        const float blast = (s0 + s1) + (s2 + s3);
        run = pre;
#pragma unroll
        for (int i8 = 0; i8 < 8; ++i8) { unsigned kp[4];
#pragma unroll
            for (int j = 0; j < 4; ++j) { const float l0 = lf[8 * i8 + 2 * j], l1 = lf[8 * i8 + 2 * j + 1]; run += l0; const float a0 = (1.f - __expf(l0)) * __expf(blast - run); run += l1; const float a1 = (1.f - __expf(l1)) * __expf(blast - run); kp[j] = pk2(a0, a1); }
            *(LAS v4u*)(KPt + k * GP + seg * 64 + 8 * i8) = (v4u){kp[0], kp[1], kp[2], kp[3]}; }
        if (seg == 0) { const float e = __expf(blast); ((float*)(ws + WS_DEC))[unit * 128 + k] = e; dl[k] = e; }
        LBAR();
#pragma unroll
        for (int kt = 0; kt < 8; ++kt) { const f32x4 d = *(const LAS f32x4*)(dl + 16 * kt + 4 * lq); R[kt] = R[kt] * d; }
#pragma unroll
        for (int ss = 0; ss < 8; ++ss) { const bf16x8 y = *(const LAS bf16x8*)(Vt + (16 * wave + l15) * GP + 32 * ss + 8 * lq);
#pragma unroll
            for (int kt = 0; kt < 8; ++kt) { const bf16x8 x = *(const LAS bf16x8*)(KPt + (16 * kt + l15) * GP + 32 * ss + 8 * lq); R[kt] = __builtin_amdgcn_mfma_f32_16x16x32_bf16(x, y, R[kt], 0, 0, 0); } }
        LBAR();
    }
    float* tp = Gp + (size_t)(256 + quad) * 16384 + (size_t)(wave * 8) * 256 + lane * 4;
#pragma unroll
    for (int kt = 0; kt < 8; ++kt) *(f32x4*)(tp + kt * 256) = R[kt];
}
template <int NR>
__device__ __forceinline__ void conv_rows(const Args& a, int r0, int rstride, int lane) {
    unsigned char* ws = a.ws; const int c0 = 8 * lane;
    const bf16* BCp = (const bf16*)(ws + WS_BC); const bf16* CUp = (const bf16*)(ws + WS_CU);
    v4u bq[NR], u0[NR], u1[NR], u2[NR];
#pragma unroll
    for (int i = 0; i < NR; ++i) { const int row = r0 + i * rstride, t = row & (SEQ - 1);
        bq[i] = *(const v4u*)(BCp + (size_t)row * 512 + c0); u0[i] = *(const v4u*)(CUp + (size_t)row * 512 + c0);
        u1[i] = (v4u){0, 0, 0, 0}; u2[i] = (v4u){0, 0, 0, 0};
        if (t >= 1) u1[i] = *(const v4u*)(CUp + (size_t)(row - 1) * 512 + c0);
        if (t >= 2) u2[i] = *(const v4u*)(CUp + (size_t)(row - 2) * 512 + c0); }
    const float* cw = a.in[I_CONVW] + c0; const float* gn = a.in[I_CONVN] + c0;
    const f32x4 w0a = *(const f32x4*)(cw), w0b = *(const f32x4*)(cw + 4), w1a = *(const f32x4*)(cw + 512), w1b = *(const f32x4*)(cw + 516), w2a = *(const f32x4*)(cw + 1024), w2b = *(const f32x4*)(cw + 1028);
    const f32x4 ga = *(const f32x4*)(gn), gb = *(const f32x4*)(gn + 4);
#pragma unroll
    for (int i = 0; i < NR; ++i) { const int row = r0 + i * rstride; float y[8]; float s = 0.f;
#pragma unroll
        for (int j = 0; j < 8; ++j) { const int sh = (j & 1) * 16; const unsigned ub = bq[i][j >> 1], x0 = u0[i][j >> 1], x1 = u1[i][j >> 1], x2 = u2[i][j >> 1];
            const float B = __uint_as_float(((ub >> sh) & 0xffffu) << 16), c_0 = __uint_as_float(((x0 >> sh) & 0xffffu) << 16), c_1 = __uint_as_float(((x1 >> sh) & 0xffffu) << 16), c_2 = __uint_as_float(((x2 >> sh) & 0xffffu) << 16);
            const float k0 = j < 4 ? w0a[j & 3] : w0b[j & 3], k1 = j < 4 ? w1a[j & 3] : w1b[j & 3], k2 = j < 4 ? w2a[j & 3] : w2b[j & 3];
            y[j] = B * (k0 * c_2 + k1 * c_1 + k2 * c_0); s += y[j] * y[j]; }
        s = wave_sum(s); const float rs = rsqrtf(s * (1.f / 512.f) + EPS);
        v4u o; o.x = pk2(y[0] * rs * ga[0], y[1] * rs * ga[1]); o.y = pk2(y[2] * rs * ga[2], y[3] * rs * ga[3]); o.z = pk2(y[4] * rs * gb[0], y[5] * rs * gb[1]); o.w = pk2(y[6] * rs * gb[2], y[7] * rs * gb[3]);
        pg8::st_wt16((bf16*)(ws + WS_MIX) + (size_t)row * 1024 + 512 + c0, o); }
}
__device__ __forceinline__ void hg_c2_unit(const Args& a, const float* Gp, LAS unsigned char* lds, int unit, int tid) {
    unsigned char* ws = a.ws;
    const int bh = unit >> 4, g = unit & 15, b = bh >> 2, h = bh & 3;
    const int k = tid & 127, seg = tid >> 7, lane = tid & 63, wave = tid >> 6, l15 = lane & 15, lq = lane >> 4;
    LAS float* dl = (LAS float*)lds;
    LAS float* segsum = (LAS float*)(lds + 512);
    LAS float* part = (LAS float*)(lds + 2560);
    LAS bf16* QT = (LAS bf16*)(lds + 4096);
    LAS bf16* Q2 = QT + 64 * 136;
    LAS bf16* KT = Q2 + 64 * 136;
    LAS bf16* Vt = KT + 64 * 136;
    LAS bf16* AT = Vt + 128 * 72;
    LAS bf16* KPt = AT + 64 * 72;
    LAS bf16* SL = KPt + 128 * 72;
    f32x4 S[8];
#pragma unroll
    for (int kt = 0; kt < 8; ++kt) S[kt] = (f32x4){0.f, 0.f, 0.f, 0.f};
    {
        LAS float* DGL = (LAS float*)(SL + 128 * 136);
        for (int i = tid; i < 16 * 128; i += NT) DGL[i] = ((const float*)(ws + WS_DEC))[bh * 16 * 128 + i];
        const int q = g >> 2, gi = g & 3;
        const float* tbase = Gp + (size_t)(256 + bh * 4) * 16384 + (size_t)(wave * 8) * 256 + lane * 4;
        f32x4 ta[8], tb[8], tc[8], pg[8];
#pragma unroll
        for (int kt = 0; kt < 8; ++kt) { const f32x4 z = {0.f, 0.f, 0.f, 0.f};
            ta[kt] = q >= 1 ? *(const f32x4*)(tbase + (size_t)(q - 1) * 16384 + kt * 256) : z;
            tb[kt] = q >= 2 ? *(const f32x4*)(tbase + (size_t)(q - 2) * 16384 + kt * 256) : z;
            tc[kt] = q >= 3 ? *(const f32x4*)(tbase + (size_t)(q - 3) * 16384 + kt * 256) : z;
            pg[kt] = gi >= 1 ? *(const f32x4*)(Gp + (size_t)unit * 16384 + (size_t)(wave * 8) * 256 + lane * 4 + kt * 256) : z; }
        LBAR();
#pragma unroll
        for (int kt = 0; kt < 8; ++kt) { const int ko = 16 * kt + 4 * lq;
            auto dgv = [&](int gg) -> f32x4 { return *(const LAS f32x4*)(DGL + gg * 128 + ko); };
            f32x4 sq = ta[kt];
            if (q >= 2) { const f32x4 w1 = dgv(4 * (q - 1)) * dgv(4 * (q - 1) + 1) * dgv(4 * (q - 1) + 2) * dgv(4 * (q - 1) + 3); sq = sq + w1 * tb[kt];
                if (q >= 3) { const f32x4 w2 = w1 * (dgv(4 * (q - 2)) * dgv(4 * (q - 2) + 1) * dgv(4 * (q - 2) + 2) * dgv(4 * (q - 2) + 3)); sq = sq + w2 * tc[kt]; } }
            f32x4 e = {1.f, 1.f, 1.f, 1.f};
            if (gi >= 1) e = e * dgv(4 * q); if (gi >= 2) e = e * dgv(4 * q + 1); if (gi >= 3) e = e * dgv(4 * q + 2);
            S[kt] = e * sq + pg[kt]; }
    }
    _Float16 nlf[16]; bf16 nvv[16], nqq[16];
    {   const size_t gofs = (size_t)(b * SEQ + g * 256 + seg * 16) * 512 + h * 128 + k;
        const _Float16* lfp = (const _Float16*)(ws + WS_LF) + gofs; const bf16* vp = (const bf16*)(ws + WS_VV) + gofs; const bf16* qp = (const bf16*)(ws + WS_QS) + gofs;
#pragma unroll
        for (int i = 0; i < 16; ++i) { nlf[i] = lfp[(size_t)i * 512]; nvv[i] = vp[(size_t)i * 512]; nqq[i] = qp[(size_t)i * 512]; } }
#pragma unroll 1
    for (int cc = 0; cc < 4; ++cc) {
        const int row0 = b * SEQ + (g * 4 + cc) * 64;
        float lf[16], bc[16]; bf16 vv[16], qq[16];
#pragma unroll
        for (int i = 0; i < 16; ++i) { lf[i] = (float)nlf[i]; vv[i] = nvv[i]; qq[i] = nqq[i]; }
#pragma unroll
        for (int kt = 0; kt < 8; ++kt) { v2u w; w.x = pk2(S[kt][0], S[kt][1]); w.y = pk2(S[kt][2], S[kt][3]); *(LAS v2u*)(SL + (16 * wave + l15) * 136 + 16 * kt + 4 * lq) = w; }
        float run = 0.f;
#pragma unroll
        for (int i = 0; i < 16; ++i) { run += lf[i]; bc[i] = run; }
        segsum[seg * 128 + k] = run;
        {   unsigned vq[8];
#pragma unroll
            for (int i = 0; i < 8; ++i) vq[i] = (unsigned)vv[2 * i] | ((unsigned)vv[2 * i + 1] << 16);
            *(LAS v4u*)(Vt + k * 72 + seg * 16) = (v4u){vq[0], vq[1], vq[2], vq[3]}; *(LAS v4u*)(Vt + k * 72 + seg * 16 + 8) = (v4u){vq[4], vq[5], vq[6], vq[7]}; }
        LBAR();
        const float s0 = segsum[k], s1 = segsum[128 + k], s2 = segsum[256 + k], s3 = segsum[384 + k];
        const float pre = (seg > 0 ? s0 : 0.f) + (seg > 1 ? s1 : 0.f) + (seg > 2 ? s2 : 0.f);
        const float br = s0 + s1, blast = (s0 + s1) + (s2 + s3);
        unsigned kp[8];
        const float Ebr = __expf(br), Ebl = __expf(blast - br);
#pragma unroll
        for (int i = 0; i < 16; ++i) { const int s = seg * 16 + i; const float bb = pre + bc[i]; const float q = bf2f(qq[i]); const float kk = 1.f - __expf(lf[i]);
            const float e1 = __expf(fminf(fmaxf(bb - br, -80.f), 80.f)), e3 = __builtin_amdgcn_rcpf(e1), e2 = e1 * Ebr, e4 = e3 * Ebl;
            const unsigned w1 = pk2(q * e1, q * e2), w3 = pk2(kk * e3, kk * e4);
            QT[s * 136 + k] = (bf16)(w1 & 0xffffu); Q2[s * 136 + k] = (bf16)(w1 >> 16); KT[s * 136 + k] = (bf16)(w3 & 0xffffu);
            if (i & 1) kp[i >> 1] |= (w3 & 0xffff0000u); else kp[i >> 1] = w3 >> 16; }
        *(LAS v4u*)(KPt + k * 72 + seg * 16) = (v4u){kp[0], kp[1], kp[2], kp[3]}; *(LAS v4u*)(KPt + k * 72 + seg * 16 + 8) = (v4u){kp[4], kp[5], kp[6], kp[7]};
        if (seg == 0) dl[k] = __expf(blast);
        if (cc < 3) {
            const size_t gofs = (size_t)(row0 + 64 + seg * 16) * 512 + h * 128 + k;
            const _Float16* lfp = (const _Float16*)(ws + WS_LF) + gofs; const bf16* vp = (const bf16*)(ws + WS_VV) + gofs; const bf16* qp = (const bf16*)(ws + WS_QS) + gofs;
#pragma unroll
            for (int i = 0; i < 16; ++i) { nlf[i] = lfp[(size_t)i * 512]; nvv[i] = vp[(size_t)i * 512]; nqq[i] = qp[(size_t)i * 512]; } }
        v2u gsw4[4]; f32x4 gn4[4];
        {   const int tq = 16 * (wave & 3) + l15; const size_t orow_ = (size_t)(row0 + tq);
#pragma unroll
            for (int n = 0; n < 4; ++n) { const int v0 = 64 * (wave >> 2) + 16 * n + 4 * lq; gsw4[n] = *(const v2u*)((const bf16*)(ws + WS_GS) + orow_ * 512 + h * 128 + v0); gn4[n] = *(const f32x4*)(a.in[I_HGN] + v0); } }
        LBAR();
        {
            const int tt = wave >> 1;
#pragma unroll
            for (int si = 0; si < 2; ++si) { const int st = 2 * (wave & 1) + si; f32x4 acc = {0.f, 0.f, 0.f, 0.f};
                if (st <= tt) {
#pragma unroll
                    for (int kk = 0; kk < 4; ++kk) { const bf16x8 x = *(const LAS bf16x8*)(KT + (16 * st + l15) * 136 + 32 * kk + 8 * lq), y = *(const LAS bf16x8*)(QT + (16 * tt + l15) * 136 + 32 * kk + 8 * lq);
                        acc = __builtin_amdgcn_mfma_f32_16x16x32_bf16(x, y, acc, 0, 0, 0); } }
                const int t = 16 * tt + l15, sb = 16 * st + 4 * lq;
#pragma unroll
                for (int r = 0; r < 4; ++r) if (sb + r > t) acc[r] = 0.f;
                v2u w; w.x = pk2(acc[0], acc[1]); w.y = pk2(acc[2], acc[3]); *(LAS v2u*)(AT + t * 72 + sb) = w; }
        }
        LBAR();
        const int tt = wave & 3, vh = wave >> 2; f32x4 acc[4];
#pragma unroll
        for (int n = 0; n < 4; ++n) acc[n] = (f32x4){0.f, 0.f, 0.f, 0.f};
#pragma unroll
        for (int kk = 0; kk < 4; ++kk) { const bf16x8 y = *(const LAS bf16x8*)(Q2 + (16 * tt + l15) * 136 + 32 * kk + 8 * lq);
#pragma unroll
            for (int n = 0; n < 4; ++n) { const bf16x8 x = *(const LAS bf16x8*)(SL + (64 * vh + 16 * n + l15) * 136 + 32 * kk + 8 * lq); acc[n] = __builtin_amdgcn_mfma_f32_16x16x32_bf16(x, y, acc[n], 0, 0, 0); } }
#pragma unroll
        for (int ss = 0; ss < 2; ++ss) { const bf16x8 y = *(const LAS bf16x8*)(AT + (16 * tt + l15) * 72 + 32 * ss + 8 * lq);
#pragma unroll
            for (int n = 0; n < 4; ++n) { const bf16x8 x = *(const LAS bf16x8*)(Vt + (64 * vh + 16 * n + l15) * 72 + 32 * ss + 8 * lq); acc[n] = __builtin_amdgcn_mfma_f32_16x16x32_bf16(x, y, acc[n], 0, 0, 0); } }
        float ssq = 0.f;
#pragma unroll
        for (int n = 0; n < 4; ++n) ssq += (acc[n][0] * acc[n][0] + acc[n][1] * acc[n][1]) + (acc[n][2] * acc[n][2] + acc[n][3] * acc[n][3]);
        ssq += __shfl_xor(ssq, 16); ssq += __shfl_xor(ssq, 32);
        const int t = 16 * tt + l15;
        if (lq == 0) part[vh * 64 + t] = ssq;
#pragma unroll
        for (int kt = 0; kt < 8; ++kt) { const f32x4 d = *(const LAS f32x4*)(dl + 16 * kt + 4 * lq); S[kt] = S[kt] * d;
#pragma unroll
            for (int ss = 0; ss < 2; ++ss) { const bf16x8 x = *(const LAS bf16x8*)(KPt + (16 * kt + l15) * 72 + 32 * ss + 8 * lq), y = *(const LAS bf16x8*)(Vt + (16 * wave + l15) * 72 + 32 * ss + 8 * lq);
                S[kt] = __builtin_amdgcn_mfma_f32_16x16x32_bf16(x, y, S[kt], 0, 0, 0); } }
        LBAR();
        const float rs = rsqrtf((part[t] + part[64 + t]) * (1.f / 128.f) + EPS);
        const size_t orow = (size_t)(row0 + t);
#pragma unroll
        for (int n = 0; n < 4; ++n) { const int v0 = 64 * vh + 16 * n + 4 * lq; const v2u gsw = gsw4[n]; const f32x4 gn = gn4[n];
            const float o0 = acc[n][0] * rs * gn[0] * __uint_as_float(gsw.x << 16), o1 = acc[n][1] * rs * gn[1] * __uint_as_float(gsw.x & 0xffff0000u);
            const float o2 = acc[n][2] * rs * gn[2] * __uint_as_float(gsw.y << 16), o3 = acc[n][3] * rs * gn[3] * __uint_as_float(gsw.y & 0xffff0000u);
            v2u w; w.x = pk2(o0, o1); w.y = pk2(o2, o3); pg8::st_wt8((bf16*)(ws + WS_MIX) + orow * 1024 + h * 128 + v0, w); }
        LBAR();
    }
}
constexpr int XP = 264;
__device__ __forceinline__ void stage_half(const bf16* g, LAS bf16* dst, int tid) {
    v4u t[8];
#pragma unroll
    for (int i = 0; i < 8; ++i) { const int ch = tid + i * NT, r = ch >> 5, cc = ch & 31; t[i] = *(const v4u*)(g + (size_t)r * 1024 + cc * 8); }
#pragma unroll
    for (int i = 0; i < 8; ++i) { const int ch = tid + i * NT, r = ch >> 5, cc = ch & 31; *(LAS v4u*)(dst + r * XP + cc * 8) = t[i]; }
}
__device__ __forceinline__ void xattn_core(unsigned char* ws, LAS unsigned char* lds, int b, int hd, int qb, int tid, const bf16x8 (&qf)[16]) {
    const int lane = tid & 63, wave = tid >> 6, r32 = lane & 31, hh = lane >> 5;
    LAS bf16* L0 = (LAS bf16*)lds; LAS bf16* L1 = L0 + 128 * XP;
    const bf16* Kg = (const bf16*)(ws + WS_KB) + (size_t)(b * 256) * 1024 + hd * 256;
    const bf16* Vg = (const bf16*)(ws + WS_VT) + (size_t)(hd * 256) * 1024 + b * 256;
    stage_half(Kg, L0, tid); stage_half(Kg + (size_t)128 * 1024, L1, tid);
    const int q0 = b * SEQ + qb * 256 + 32 * wave;
    __syncthreads();
    f32x16 sacc[8];
#pragma unroll
    for (int mt = 0; mt < 8; ++mt) {
#pragma unroll
        for (int r = 0; r < 16; ++r) sacc[mt][r] = 0.f;
        const LAS bf16* kp = (mt < 4 ? L0 : L1) + ((mt & 3) * 32 + r32) * XP + 8 * hh;
#pragma unroll
        for (int ds = 0; ds < 16; ++ds) { const bf16x8 kf = *(const LAS bf16x8*)(kp + 16 * ds); sacc[mt] = __builtin_amdgcn_mfma_f32_32x32x16_bf16(kf, qf[ds], sacc[mt], 0, 0, 0); } }
    __syncthreads();
    stage_half(Vg, L0, tid); stage_half(Vg + (size_t)128 * 1024, L1, tid);
    float mx = -3.0e38f;
#pragma unroll
    for (int mt = 0; mt < 8; ++mt)
#pragma unroll
        for (int r = 0; r < 16; ++r) mx = fmaxf(mx, sacc[mt][r]);
    mx = fmaxf(mx, __shfl_xor(mx, 32));
    float sum = 0.f; bf16x8 pf[8][2];
#pragma unroll
    for (int mt = 0; mt < 8; ++mt) {
        float e[16];
#pragma unroll
        for (int r = 0; r < 16; ++r) { e[r] = __expf(sacc[mt][r] - mx); sum += e[r]; }
#pragma unroll
        for (int s = 0; s < 2; ++s) { v4u w; w.x = pk2(e[8 * s], e[8 * s + 1]); w.y = pk2(e[8 * s + 2], e[8 * s + 3]); w.z = pk2(e[8 * s + 4], e[8 * s + 5]); w.w = pk2(e[8 * s + 6], e[8 * s + 7]); pf[mt][s] = __builtin_bit_cast(bf16x8, w); }
    }
    sum += __shfl_xor(sum, 32);
    const float inv = 1.f / sum;
    __syncthreads();
    bf16* op = (bf16*)(ws + WS_O) + (size_t)(q0 + r32) * 1024 + hd * 256 + 4 * hh;
#pragma unroll 1
    for (int dt = 0; dt < 8; ++dt) {
        f32x16 o;
#pragma unroll
        for (int r = 0; r < 16; ++r) o[r] = 0.f;
        const LAS bf16* vpb = (dt < 4 ? L0 : L1) + ((dt & 3) * 32 + r32) * XP + 4 * hh;
#pragma unroll
        for (int mt = 0; mt < 8; ++mt)
#pragma unroll
            for (int s = 0; s < 2; ++s) { const v2u lo = *(const LAS v2u*)(vpb + 32 * mt + 16 * s), hi = *(const LAS v2u*)(vpb + 32 * mt + 16 * s + 8);
                const v4u vw = {lo.x, lo.y, hi.x, hi.y}; o = __builtin_amdgcn_mfma_f32_32x32x16_bf16(__builtin_bit_cast(bf16x8, vw), pf[mt][s], o, 0, 0, 0); }
#pragma unroll
        for (int g = 0; g < 4; ++g) { v2u w; w.x = pk2(o[4 * g] * inv, o[4 * g + 1] * inv); w.y = pk2(o[4 * g + 2] * inv, o[4 * g + 3] * inv); pg8::st_wt8(op + 32 * dt + 8 * g, w); }
    }
    __syncthreads();
}

struct EpiAttn {
    static constexpr bool PERM = false, AFTER_DRAIN = true;
    unsigned char* ws; const float* ssq; unsigned* psync;
    __device__ __forceinline__ void fused(f32x4 (&acc)[2][2][4][2], const pg8::Unit& u, int wr, int wc, int fr, int fq, LAS unsigned char* lds, int wid, int lane) const {
        LAS bf16* QI = (LAS bf16*)lds;
#pragma unroll
        for (int ai = 0; ai < 2; ++ai)
#pragma unroll
            for (int m = 0; m < 4; ++m) { const int rl = ai * 128 + wr * 64 + m * 16 + fr; const float rs = pg8::row_rs(ssq, u.pm * 256 + rl);
#pragma unroll
                for (int bj = 0; bj < 2; ++bj)
#pragma unroll
                    for (int n = 0; n < 2; ++n) { const f32x4 v = acc[ai][bj][m][n] * rs; v2u w; w.x = pk2(v[0], v[1]); w.y = pk2(v[2], v[3]);
                        *(LAS v2u*)(QI + rl * XP + bj * 128 + wc * 32 + n * 16 + 4 * fq) = w; } }
        __syncthreads();
        const int r32 = lane & 31, hh = lane >> 5; bf16x8 qf[16];
#pragma unroll
        for (int ds = 0; ds < 16; ++ds) qf[ds] = *(const LAS bf16x8*)(QI + (32 * wid + r32) * XP + 16 * ds + 8 * hh);
        __syncthreads();
        xattn_core(ws, lds, u.pm >> 4, u.pn, u.pm & 15, wid * 64 + lane, qf);
        if (psync) pg8::panel_sync(psync, u.pm, wid, lane);
    }
};

#define XB_TMO      128
#define XB_XCNT(j)  (256  + 64 * (j))
#define XB_XSUB(j)  (1280 + 64 * (j))
#define XB_XGEN(j)  (2304 + 64 * (j))
#define XB_TOP      3328
#define XB_TOPGEN   3392
#define XCD_BAR_WORDS 3456
#define XB_SPIN_CAP (1u << 18)

__device__ __forceinline__ unsigned xb_ld(unsigned* p)              { return __hip_atomic_load(p, __ATOMIC_RELAXED, __HIP_MEMORY_SCOPE_AGENT); }
__device__ __forceinline__ unsigned xb_add(unsigned* p, unsigned v) { return __hip_atomic_fetch_add(p, v, __ATOMIC_RELAXED, __HIP_MEMORY_SCOPE_AGENT); }
__device__ __forceinline__ unsigned xb_xcc_id() { return (unsigned)__builtin_amdgcn_s_getreg((3 << 11) | 20) & 0xFu; }
#define XB_SPIN(cond, bar) do { unsigned _sp = 0; while (cond) { __builtin_amdgcn_s_sleep(1); \
    if ((++_sp & 255u) == 0u) { if (xb_ld(&(bar)[XB_TMO])) break; if (_sp > XB_SPIN_CAP) { atomicAdd(&(bar)[XB_TMO], 1u); break; } } } } while (0)

struct XcdBarrier {
    unsigned* bar; unsigned x;
    volatile LAS unsigned* st;
};

__device__ __forceinline__ XcdBarrier xcd_barrier_post(unsigned* bar, volatile LAS unsigned* st) {
    XcdBarrier b; b.bar = bar; b.x = xb_xcc_id(); b.st = st;
    if (threadIdx.x == 0) (void)xb_add(&bar[XB_XCNT(b.x)], 1u);
    return b;
}
__device__ __forceinline__ void xcd_barrier_complete(unsigned* bar, unsigned x, unsigned& nloc, unsigned& nx) {
    const unsigned G = gridDim.x * gridDim.y * gridDim.z;
    unsigned sum, cnt, mine, sp = 0u;
    for (;;) {
        sum = 0u; cnt = 0u; mine = 0u;
#pragma unroll
        for (unsigned j = 0; j < 16; ++j) { const unsigned c = xb_ld(&bar[XB_XCNT(j)]); sum += c; cnt += (c > 0u) ? 1u : 0u; mine = (j == x) ? c : mine; }
        if (sum == G) break;
        __builtin_amdgcn_s_sleep(1);
        if ((++sp & 255u) == 0u) { if (xb_ld(&bar[XB_TMO])) break; if (sp > XB_SPIN_CAP) { atomicAdd(&bar[XB_TMO], 1u); break; } }
    }
    nloc = mine > 0u ? mine : 1u; nx = cnt > 0u ? cnt : 1u;
}

__device__ __forceinline__ void xcd_barrier(const XcdBarrier& b) {
    asm volatile("s_waitcnt vmcnt(0)" ::: "memory");
    __syncthreads();
    if (threadIdx.x == 0) {
        unsigned* bar = b.bar;
        __builtin_amdgcn_s_waitcnt(0);
        unsigned nloc = b.st[0], nx = b.st[1];
        if (nloc == 0u) { xcd_barrier_complete(bar, b.x, nloc, nx); b.st[0] = nloc; b.st[1] = nx; }
        const unsigned old = xb_add(&bar[XB_XSUB(b.x)], 1u);
        const unsigned gen = old / nloc;
        if (old + 1u == (gen + 1u) * nloc) {
            __builtin_amdgcn_fence(__ATOMIC_RELEASE, "agent");
            asm volatile("s_waitcnt vmcnt(0)" ::: "memory");
            const unsigned og = xb_add(&bar[XB_TOP], 1u);
            const unsigned tg = og / nx;
            if (og + 1u == (tg + 1u) * nx) xb_add(&bar[XB_TOPGEN], 1u);
            else XB_SPIN(xb_ld(&bar[XB_TOPGEN]) == tg, bar);
            __builtin_amdgcn_fence(__ATOMIC_ACQUIRE, "agent");
            xb_add(&bar[XB_XGEN(b.x)], 1u);
            asm volatile("s_waitcnt vmcnt(0)" ::: "memory");
        } else {
            XB_SPIN(xb_ld(&bar[XB_XGEN(b.x)]) == gen, bar);
            __builtin_amdgcn_fence(__ATOMIC_ACQUIRE, "agent");
            asm volatile("s_waitcnt vmcnt(0)" ::: "memory");
        }
    }
    __syncthreads();
}

#ifndef FLAT_BAR
#define FLAT_BAR 0
#endif
__device__ __forceinline__ void flat_barrier(unsigned* cnt, unsigned& gen, unsigned G) {
    asm volatile("s_waitcnt vmcnt(0)" ::: "memory");
    __syncthreads();
    if (threadIdx.x == 0) {
        __builtin_amdgcn_fence(__ATOMIC_RELEASE, "agent");
        asm volatile("s_waitcnt vmcnt(0)" ::: "memory");
        __hip_atomic_fetch_add(cnt + 64 * (blockIdx.x & 7u), 1u, __ATOMIC_RELAXED, __HIP_MEMORY_SCOPE_AGENT);
        const unsigned target = (gen + 1u) * G; unsigned sp = 0;
        for (;;) { unsigned sum = 0;
#pragma unroll
            for (int j = 0; j < 8; ++j) sum += __hip_atomic_load(cnt + 64 * j, __ATOMIC_RELAXED, __HIP_MEMORY_SCOPE_AGENT);
            if (sum >= target) break;
            __builtin_amdgcn_s_sleep(1);
            if (++sp > (1u << 20)) break; }
        __builtin_amdgcn_fence(__ATOMIC_ACQUIRE, "agent");
        asm volatile("s_waitcnt vmcnt(0)" ::: "memory");
    }
    ++gen;
    __syncthreads();
}

constexpr int N_PHASES = 14;
#ifndef DUPMASK
#define DUPMASK 0
#endif
#define NREP(k) (1 + ((DUPMASK >> (k)) & 1))
__global__ void __launch_bounds__(NT, 2) hymba_fwd(Args args) {
    extern __shared__ __attribute__((aligned(16))) unsigned char lds_raw[];
    LAS unsigned char* lds = (LAS unsigned char*)lds_raw;
    const int tid = threadIdx.x, lane = tid & 63, wave = __builtin_amdgcn_readfirstlane(tid >> 6);
    const int G = gridDim.x, bx = blockIdx.x;
    const int vcu = (G % 8 == 0) ? (bx % 8) * (G / 8) + bx / 8 : bx;
    const int gw = vcu * NWAVES + wave, NGW = G * NWAVES;
    unsigned char* ws = args.ws;
    float* ssq = (float*)(ws + WS_SSQ);
    const int lo = args.ph_lo, hi = args.ph_hi;
#define IN(k) (lo <= (k) && (k) < hi)
#if FLAT_BAR
    unsigned fgen = 0;
#define SEAM(k) do { if (IN(k) && IN((k) + 1)) flat_barrier((unsigned*)(ws + WS_BAR + 65536), fgen, (unsigned)G); } while (0)
#else
#define SEAM(k) do { if (IN(k) && IN((k) + 1)) xcd_barrier(xbar); } while (0)
#endif
    bf16* XB = (bf16*)(ws + WS_XB); bf16* Hb = (bf16*)(ws + WS_H);
    if (lo < 0) cg::this_grid().sync();
    volatile LAS unsigned* MISC = (volatile LAS unsigned*)(lds + MISC_OFF);
    if (tid < 16) MISC[tid] = 0u;
    __syncthreads();
    XcdBarrier xbar = xcd_barrier_post((unsigned*)(ws + WS_BAR), MISC);

    if (IN(0)) { for (int rep = 0; rep < NREP(0); ++rep) p0_prologue(args, lds, gw, NGW, wave, lane); }
    SEAM(0);
    if (IN(1)) _Pragma("unroll") for (int rep = 0; rep < NREP(1); ++rep) {
        { pg8::Gemm g{XB, (const bf16*)(ws + WS_WGU1), M, 2 * FF, D}; pg8::StaticOrder S; S.init(M, 2 * FF, G, bx);
          pg8::EpiSwiglu E{Hb, FF, ssq}; pg8::gemm_phase<pg8::EpiSwiglu, pg8::StaticOrder, true, true>(lds, g, S, E); }
        { pg8::Gemm g{(const bf16*)(ws + WS_MEMN), (const bf16*)(ws + WS_WKV), NB * NMEM, D, D}; pg8::StaticOrder S; S.init(NB * NMEM, D, G, (bx + G - 128) % G);
          pg8::EpiScale E{(bf16*)(ws + WS_KB), D, nullptr}; pg8::gemm_phase<pg8::EpiScale, pg8::StaticOrder, true, true>(lds, g, S, E); }
        { pg8::Gemm g{(const bf16*)(ws + WS_WKV) + (size_t)D * D, (const bf16*)(ws + WS_MEMN), D, NB * NMEM, D}; pg8::StaticOrder S; S.init(D, NB * NMEM, G, (bx + G - 144) % G);
          pg8::EpiScale E{(bf16*)(ws + WS_VT), NB * NMEM, nullptr}; pg8::gemm_phase<pg8::EpiScale, pg8::StaticOrder, true, true>(lds, g, S, E); }
        if (G == 256 && bx >= 160) p0_items(args, (LAS float*)(lds + wave * 16384), P0_EARLY, P0_MID, (bx - 160) * NWAVES + wave, 96 * NWAVES, lane);
        else if (G != 256) p0_items(args, (LAS float*)(lds + wave * 16384), P0_EARLY, P0_MID, bx * NWAVES + wave, NGW, lane);
    }
    SEAM(1);
    if (IN(2)) {
        pg8::Gemm g{Hb, (const bf16*)(ws + WS_WD1), M, D, FF}; pg8::StaticOrder S; S.init(M, D, G, bx);
        pg8::EpiResid E{nullptr  , XB, ssq + M, 0.5f, nullptr}; pg8::gemm_phase<pg8::EpiResid, pg8::StaticOrder, false, true>(lds, g, S, E);
    }
    SEAM(2);
    if (IN(3)) _Pragma("unroll") for (int rep = 0; rep < NREP(3); ++rep) {
        pg8::Gemm g{XB, (const bf16*)(ws + WS_WIN), M, 2048, D}; pg8::StaticOrder S; S.init(M, 2048, G, bx);
        pg8::EpiWin E{(bf16*)(ws + WS_QS), (bf16*)(ws + WS_VV), (bf16*)(ws + WS_GS), (bf16*)(ws + WS_BC), (bf16*)(ws + WS_CU), (_Float16*)(ws + WS_LF), ssq + M, args.in[I_LB], 0};
        pg8::gemm_phase<pg8::EpiWin, pg8::StaticOrder, true, true>(lds, g, S, E);
    }
    SEAM(3);
    if (IN(4)) _Pragma("unroll") for (int rep = 0; rep < NREP(4); ++rep) {
        const int GA = (G * 3) / 4;
        if (bx < GA) {
            pg8::Gemm g{XB, (const bf16*)(ws + WS_WIN) + (size_t)2048 * D, M, 1536, D}; pg8::StaticOrder S; S.init(M, 1536, GA, bx);
            pg8::EpiWin E{(bf16*)(ws + WS_QS), (bf16*)(ws + WS_VV), (bf16*)(ws + WS_GS), (bf16*)(ws + WS_BC), (bf16*)(ws + WS_CU), (_Float16*)(ws + WS_LF), ssq + M, args.in[I_LB], 8};
            pg8::gemm_phase<pg8::EpiWin, pg8::StaticOrder, true, true>(lds, g, S, E);
        } else {
            for (int qd = bx - GA; qd < 64; qd += G - GA) hg_a2_quad(ws, args.out, lds, qd, tid);
        }
    }
    if (IN(4)) p0_items(args, (LAS float*)(lds + wave * 16384), P0_MID, P0_GU2, gw, NGW, lane);
    SEAM(4);
    if (IN(5)) _Pragma("unroll") for (int rep = 0; rep < NREP(5); ++rep) {
        if (M % (4 * NGW) == 0) { for (int r = gw; r < M; r += 4 * NGW) conv_rows<4>(args, r, NGW, lane); } else { for (int r = gw; r < M; r += NGW) conv_rows<1>(args, r, NGW, lane); }
        for (int u = vcu; u < 256; u += G) hg_c2_unit(args, args.out, lds, u, tid);
    }
    SEAM(5);
    if (IN(7)) {
        pg8::Gemm g{(const bf16*)(ws + WS_MIX), (const bf16*)(ws + WS_WOUT), M, D, D}; pg8::StaticOrder S; S.init(M, D, G, bx);
        pg8::EpiResid E{nullptr, XB, ssq + 2 * M, 1.f, nullptr}; pg8::gemm_phase<pg8::EpiResid, pg8::StaticOrder, false, true>(lds, g, S, E);
    }
    SEAM(7);
    if (IN(8)) _Pragma("unroll") for (int rep = 0; rep < NREP(8); ++rep) {
        pg8::Gemm g{XB, (const bf16*)(ws + WS_WQ), M, D, D}; pg8::StaticOrder S; S.init(M, D, G, bx);
        EpiAttn E{ws, ssq + 2 * M, nullptr}; pg8::gemm_phase<EpiAttn, pg8::StaticOrder, false, true>(lds, g, S, E);
    }
    SEAM(8);
    if (IN(10)) {
        pg8::Gemm g{(const bf16*)(ws + WS_O), (const bf16*)(ws + WS_WO), M, D, D}; pg8::StaticOrder S; S.init(M, D, G, bx);
        pg8::EpiResid E{nullptr, XB, ssq + 3 * M, 1.f, nullptr}; pg8::gemm_phase<pg8::EpiResid, pg8::StaticOrder, false, true>(lds, g, S, E);
    }
    SEAM(10);
    if (IN(11)) _Pragma("unroll") for (int rep = 0; rep < NREP(11); ++rep) {
        pg8::Gemm g{XB, (const bf16*)(ws + WS_WGU2), M, 2 * FF, D}; pg8::StaticOrder S; S.init(M, 2 * FF, G, bx);
        pg8::EpiSwiglu E{Hb, FF, ssq + 3 * M}; pg8::gemm_phase<pg8::EpiSwiglu, pg8::StaticOrder, true, true>(lds, g, S, E);
        if (G == 256 && bx >= 128) p0_items(args, (LAS float*)(lds + wave * 16384), P0_GU2, P0_ALL, (bx - 128) * NWAVES + wave, 128 * NWAVES, lane);
        else if (G != 256) p0_items(args, (LAS float*)(lds + wave * 16384), P0_GU2, P0_ALL, bx * NWAVES + wave, NGW, lane);
    }
    SEAM(11);
    if (IN(12)) {
        pg8::Gemm g{Hb, (const bf16*)(ws + WS_WD2), M, D, FF}; pg8::StaticOrder S; S.init(M, D, G, bx);
        pg8::EpiFinal E{XB, args.out, ssq + 4 * M, (unsigned*)(ws + WS_CNT), args.in[I_FINN], 0.5f}; pg8::gemm_phase<pg8::EpiFinal, pg8::StaticOrder, false, true>(lds, g, S, E);
    }
#undef IN
#undef SEAM
}

#ifndef MK_N_LAUNCHES
#define MK_N_LAUNCHES 1
#endif
extern "C" void kernel_launch(void* const* d_in, const int* in_sizes, int n_in, void* d_out, int out_size, void* d_ws, size_t ws_size, hipStream_t stream) {
    static int grid = 0;
    if (grid == 0) {
        if (n_in != 21 || out_size != M * D || ws_size < WS_END) { fprintf(stderr, "kernel_launch: unexpected problem (n_in %d out %d ws %zu)\n", n_in, out_size, ws_size); grid = -1; return; }
        int dev = 0, cus = 0, per_cu = 0;
        hipGetDevice(&dev); hipDeviceGetAttribute(&cus, hipDeviceAttributeMultiprocessorCount, dev);
        if (hipFuncSetAttribute((const void*)hymba_fwd, hipFuncAttributeMaxDynamicSharedMemorySize, LDS_BYTES) != hipSuccess) { fprintf(stderr, "kernel_launch: hipFuncSetAttribute failed\n"); grid = -1; return; }
        hipOccupancyMaxActiveBlocksPerMultiprocessor(&per_cu, (const void*)hymba_fwd, NT, LDS_BYTES);
        (void)hipGetLastError();
        if (per_cu < 1) per_cu = 1;
        grid = cus * 1;
        if (grid <= 0) grid = 256;
    }
    if (grid < 0) return;
    Args a{};
    for (int i = 0; i < 21; ++i) a.in[i] = (const float*)d_in[i];
    a.out = (float*)d_out; a.ws = (unsigned char*)d_ws;
#if MK_N_LAUNCHES == 1
    if (hipMemsetAsync((char*)d_ws + WS_BAR, 0, BAR_BYTES, stream) != hipSuccess) { fprintf(stderr, "kernel_launch: memset failed\n"); return; }
    a.ph_lo = 0; a.ph_hi = N_PHASES;
    void* kargs[] = {&a};
    hipError_t e = hipLaunchCooperativeKernel((const void*)hymba_fwd, dim3(grid), dim3(NT), kargs, LDS_BYTES, stream);
    if (e != hipSuccess) fprintf(stderr, "cooperative launch failed: %s (grid %d)\n", hipGetErrorString(e), grid);
#else
    for (int p = 0; p < N_PHASES; ++p) { a.ph_lo = p; a.ph_hi = p + 1; hipLaunchKernelGGL(hymba_fwd, dim3(grid), dim3(NT), LDS_BYTES, stream, a); }
#endif
}
```
